# Optimizing an MI355X kernel written in HIP

```python
import jax, jax.numpy as jnp
from jax import lax
import numpy as np

D_MODEL = 1024
BATCH = 4
SEQ = 8192
DEPTH = 4

GRID_W = 64
CTX_LEN = 256
HEAD_DIM = 64
N_Q_HEADS = 8
N_KV_HEADS = 2
Q_PER_KV = N_Q_HEADS // N_KV_HEADS
ATT_WIDTH = N_Q_HEADS * HEAD_DIM
KV_WIDTH = N_KV_HEADS * HEAD_DIM
WINDOW = 128
BLOCK = 128
POOL_WINDOWS = (2, 4, 8, 16)
N_POOL_GROUPS = 4
POOL_WIDTH = D_MODEL // 2
POOL_GROUP = POOL_WIDTH // N_POOL_GROUPS
N_BRANCHES = 2
IN_WIDTH = ATT_WIDTH + 2 * KV_WIDTH + POOL_WIDTH + N_BRANCHES * D_MODEL
N_MOD = 6
D_FF = 2816
N_EXPERTS = 8
TOP_K = 2
D_FF_EXPERT = 3584
ROPE_BASE = 10000.0
EPS = 1e-6
N_DENSE = (DEPTH + 1) // 2
N_MOE = DEPTH // 2
NEG_INF = -1e30

kernel_name = "hybrid_gated_swa_pool_moe_dit"


def rms_norm(x, g):
    xf = x.astype(jnp.float32)
    y = xf * lax.rsqrt(jnp.mean(xf * xf, axis=-1, keepdims=True) + EPS)
    return (y * g.astype(jnp.float32)).astype(x.dtype)


def modulate(h, shift, scale):
    return h * (1 + scale) + shift


def rope_axis(x, pos):
    half = x.shape[-1] // 2
    freqs = ROPE_BASE ** (-jnp.arange(half, dtype=jnp.float32) / half)
    ang = pos.astype(jnp.float32)[:, None] * freqs[None, :]
    cos = jnp.cos(ang)[None, :, None, :].astype(x.dtype)
    sin = jnp.sin(ang)[None, :, None, :].astype(x.dtype)
    x1, x2 = x[..., :half], x[..., half:]
    return jnp.concatenate([x1 * cos - x2 * sin, x2 * cos + x1 * sin], axis=-1)


def rope_2d(x, row, col):
    r = HEAD_DIM // 2
    return jnp.concatenate([rope_axis(x[..., :r], row), rope_axis(x[..., r:], col)], axis=-1)


def sink_softmax(scores, sinks):
    sink = sinks.astype(jnp.float32).reshape(1, N_KV_HEADS, Q_PER_KV, 1, 1)
    lead = scores.ndim - 4
    sink = sink.reshape((1,) * (lead - 1) + sink.shape)
    sink = jnp.broadcast_to(sink, scores.shape[:-1] + (1,))
    p = jax.nn.softmax(jnp.concatenate([scores, sink], axis=-1), axis=-1)
    return p[..., :-1]


def split_proj(u):
    o1 = ATT_WIDTH
    o2 = o1 + KV_WIDTH
    o3 = o2 + KV_WIDTH
    o4 = o3 + POOL_WIDTH
    return u[..., :o1], u[..., o1:o2], u[..., o2:o3], u[..., o3:o4], u[..., o4:]


def context_attention(qc, kc, vc, sinks):
    scale = HEAD_DIM ** -0.5
    s = jnp.einsum('bqhgd,bkhd->bhgqk', qc, kc).astype(jnp.float32) * scale
    p = sink_softmax(s, sinks).astype(vc.dtype)
    o = jnp.einsum('bhgqk,bkhd->bqhgd', p, vc)
    return o.reshape(o.shape[0], o.shape[1], ATT_WIDTH)


def latent_attention(q, k, v, kc, vc, sinks):
    B, L = q.shape[0], q.shape[1]
    nb = L // BLOCK
    scale = HEAD_DIM ** -0.5
    qb = q.reshape(B, nb, BLOCK, N_KV_HEADS, Q_PER_KV, HEAD_DIM)
    pad = ((0, 0), (BLOCK, BLOCK), (0, 0), (0, 0))
    kp = jnp.pad(k, pad).reshape(B, nb + 2, BLOCK, N_KV_HEADS, HEAD_DIM)
    vp = jnp.pad(v, pad).reshape(B, nb + 2, BLOCK, N_KV_HEADS, HEAD_DIM)
    k_win = jnp.concatenate([kp[:, :-2], kp[:, 1:-1], kp[:, 2:]], axis=2)
    v_win = jnp.concatenate([vp[:, :-2], vp[:, 1:-1], vp[:, 2:]], axis=2)
    blk = jnp.arange(nb)
    qpos = blk[:, None] * BLOCK + jnp.arange(BLOCK)[None, :]
    kpos = blk[:, None] * BLOCK - BLOCK + jnp.arange(3 * BLOCK)[None, :]
    valid = ((jnp.abs(qpos[:, :, None] - kpos[:, None, :]) <= WINDOW)
             & (kpos >= 0)[:, None, :] & (kpos < L)[:, None, :])

    def block_fn(args):
        qi, ki, vi, mi = args
        s_loc = jnp.einsum('bqhgd,bkhd->bhgqk', qi, ki).astype(jnp.float32) * scale
        s_loc = jnp.where(mi[None, None, None], s_loc, NEG_INF)
        s_ctx = jnp.einsum('bqhgd,bkhd->bhgqk', qi, kc).astype(jnp.float32) * scale
        p = sink_softmax(jnp.concatenate([s_loc, s_ctx], axis=-1), sinks).astype(vi.dtype)
        return (jnp.einsum('bhgqk,bkhd->bqhgd', p[..., :3 * BLOCK], vi)
                + jnp.einsum('bhgqk,bkhd->bqhgd', p[..., 3 * BLOCK:], vc))

    o = lax.map(block_fn, (jnp.moveaxis(qb, 1, 0), jnp.moveaxis(k_win, 1, 0),
                           jnp.moveaxis(v_win, 1, 0), valid))
    return jnp.moveaxis(o, 0, 1).reshape(B, L, ATT_WIDTH)


def multiscale_pool(p, w_grp, pool_scale):
    B, L, _ = p.shape
    pf = p.astype(jnp.float32)
    cs = jnp.concatenate([jnp.zeros((B, 1, POOL_WIDTH), jnp.float32), jnp.cumsum(pf, axis=1)], axis=1)
    t = jnp.arange(L)
    means = []
    for gi, w in enumerate(POOL_WINDOWS):
        lo = jnp.clip(t - w // 2, 0, L)
        hi = jnp.clip(t + w // 2, 0, L)
        csg = cs[..., gi * POOL_GROUP:(gi + 1) * POOL_GROUP]
        sums = jnp.take(csg, hi, axis=1) - jnp.take(csg, lo, axis=1)
        means.append(sums / (hi - lo).astype(jnp.float32)[None, :, None])
    pooled = (jnp.concatenate(means, axis=-1) - pf).astype(p.dtype)
    pooled = pooled.reshape(B, L, N_POOL_GROUPS, POOL_GROUP)
    mixed = jnp.einsum('blgc,gcd->blgd', pooled, w_grp).reshape(B, L, POOL_WIDTH)
    return mixed * pool_scale


def merge_branches(att, pool, gate_logits, w_att_o, w_pool_o, w_out):
    g = jax.nn.sigmoid(gate_logits).reshape(gate_logits.shape[:-1] + (N_BRANCHES, D_MODEL))
    merged = g[..., 0, :] * (att @ w_att_o) + g[..., 1, :] * (pool @ w_pool_o)
    return merged @ w_out


def swiglu(h, wg, wu, wd):
    return (jax.nn.silu(h @ wg) * (h @ wu)) @ wd


def moe_ffn(h, w_router, b_router, wg, wu, wd):
    logits = (h @ w_router).astype(jnp.float32) + b_router.astype(jnp.float32)
    top_val, top_idx = lax.top_k(logits, TOP_K)
    top_w = jax.nn.softmax(top_val, axis=-1)
    combine = jnp.sum(jax.nn.one_hot(top_idx, N_EXPERTS, dtype=jnp.float32) * top_w[..., None], axis=-2)
    combine = combine.astype(h.dtype)
    out = jnp.zeros_like(h)
    for e in range(N_EXPERTS):
        out = out + combine[..., e:e + 1] * swiglu(h, wg[e], wu[e], wd[e])
    return out


def setup_inputs(seed: int = 0) -> dict:
    key = jax.random.key(seed)
    ks = jax.random.split(key, 24)
    f32 = jnp.float32
    n = lambda k, shape, s: jax.random.normal(k, shape, f32) * s
    D = D_MODEL
    return {
        "x": n(ks[0], (BATCH, SEQ, D), 1.0),
        "c": n(ks[1], (BATCH, D), 1.0),
        "ctx": n(ks[2], (BATCH, CTX_LEN, D), 1.0),
        "c_ctx": n(ks[3], (D,), 1.0),
        "w_mod": n(ks[4], (DEPTH, D, N_MOD * D), 0.5 * D ** -0.5),
        "b_mod": n(ks[5], (DEPTH, N_MOD * D), 0.02),
        "norm_g": 1.0 + n(ks[6], (DEPTH, 4, D), 0.02),
        "w_in": n(ks[7], (DEPTH, D, IN_WIDTH), D ** -0.5),
        "sinks": n(ks[8], (DEPTH, N_Q_HEADS), 0.5),
        "w_att_o": n(ks[9], (DEPTH, ATT_WIDTH, D), ATT_WIDTH ** -0.5),
        "pool_w": n(ks[10], (DEPTH, N_POOL_GROUPS, POOL_GROUP, POOL_GROUP), POOL_GROUP ** -0.5),
        "pool_scale": 1.0 + n(ks[11], (DEPTH, POOL_WIDTH), 0.1),
        "w_pool_o": n(ks[12], (DEPTH, POOL_WIDTH, D), POOL_WIDTH ** -0.5),
        "w_out": n(ks[13], (DEPTH, D, D), D ** -0.5),
        "w_ffn_gate": n(ks[14], (N_DENSE, D, D_FF), D ** -0.5),
        "w_ffn_up": n(ks[15], (N_DENSE, D, D_FF), D ** -0.5),
        "w_ffn_down": n(ks[16], (N_DENSE, D_FF, D), D_FF ** -0.5),
        "w_router": n(ks[17], (N_MOE, D, N_EXPERTS), D ** -0.5),
        "b_router": n(ks[18], (N_MOE, N_EXPERTS), 0.01),
        "w_exp_gate": n(ks[19], (N_MOE, N_EXPERTS, D, D_FF_EXPERT), D ** -0.5),
        "w_exp_up": n(ks[20], (N_MOE, N_EXPERTS, D, D_FF_EXPERT), D ** -0.5),
        "w_exp_down": n(ks[21], (N_MOE, N_EXPERTS, D_FF_EXPERT, D), D_FF_EXPERT ** -0.5),
    }


def reference(x, c, ctx, c_ctx, w_mod, b_mod, norm_g, w_in, sinks, w_att_o, pool_w, pool_scale,
              w_pool_o, w_out, w_ffn_gate, w_ffn_up, w_ffn_down, w_router, b_router,
              w_exp_gate, w_exp_up, w_exp_down):
    B, L, _ = x.shape
    C = ctx.shape[1]
    rows = L // GRID_W
    row = jnp.repeat(jnp.arange(rows), GRID_W)
    col = jnp.tile(jnp.arange(GRID_W), rows)
    sc = jax.nn.silu(c)
    sc_ctx = jax.nn.silu(c_ctx)

    def ffn(h, l):
        if l % 2 == 0:
            i = l // 2
            return swiglu(h, w_ffn_gate[i], w_ffn_up[i], w_ffn_down[i])
        i = l // 2
        return moe_ffn(h, w_router[i], b_router[i], w_exp_gate[i], w_exp_up[i], w_exp_down[i])

    for l in range(DEPTH):
        last = l == DEPTH - 1
        mod_lat = (sc @ w_mod[l] + b_mod[l])[:, None, :]
        mod_ctx = sc_ctx @ w_mod[l] + b_mod[l]
        sa, ca, ga, sf, cf, gf = jnp.split(mod_lat, N_MOD, axis=-1)
        sa_c, ca_c, ga_c, sf_c, cf_c, gf_c = jnp.split(mod_ctx, N_MOD, axis=-1)

        h = modulate(rms_norm(x, norm_g[l, 0]), sa, ca)
        hc = modulate(rms_norm(ctx, norm_g[l, 0]), sa_c, ca_c)
        q, k, v, p, gl = split_proj(h @ w_in[l])
        qc, kc, vc, pc, glc = split_proj(hc @ w_in[l])
        q = rope_2d(q.reshape(B, L, N_Q_HEADS, HEAD_DIM), row, col)
        k = rope_2d(k.reshape(B, L, N_KV_HEADS, HEAD_DIM), row, col)
        q = q.reshape(B, L, N_KV_HEADS, Q_PER_KV, HEAD_DIM)
        v = v.reshape(B, L, N_KV_HEADS, HEAD_DIM)
        kc = kc.reshape(B, C, N_KV_HEADS, HEAD_DIM)
        vc = vc.reshape(B, C, N_KV_HEADS, HEAD_DIM)
        att = latent_attention(q, k, v, kc, vc, sinks[l])
        pool = multiscale_pool(p, pool_w[l], pool_scale[l])
        y = merge_branches(att, pool, gl, w_att_o[l], w_pool_o[l], w_out[l])
        x = x + ga * rms_norm(y, norm_g[l, 1])

        hf = modulate(rms_norm(x, norm_g[l, 2]), sf, cf)
        x = x + gf * rms_norm(ffn(hf, l), norm_g[l, 3])

        if not last:
            qc = qc.reshape(B, C, N_KV_HEADS, Q_PER_KV, HEAD_DIM)
            att_c = context_attention(qc, kc, vc, sinks[l])
            pool_c = multiscale_pool(pc, pool_w[l], pool_scale[l])
            yc = merge_branches(att_c, pool_c, glc, w_att_o[l], w_pool_o[l], w_out[l])
            ctx = ctx + ga_c * rms_norm(yc, norm_g[l, 1])
            hfc = modulate(rms_norm(ctx, norm_g[l, 2]), sf_c, cf_c)
            ctx = ctx + gf_c * rms_norm(ffn(hfc, l), norm_g[l, 3])
    return x
```

```cpp
#include <hip/hip_runtime.h>
#include <cstdio>
#include <cstdint>
#include <cmath>
namespace pg8 {
#define PG8_LAS __attribute__((address_space(3)))
typedef unsigned short bf16_t;
typedef short bf16x8 __attribute__((ext_vector_type(8)));
typedef float f32x4 __attribute__((ext_vector_type(4)));
typedef unsigned u32x4 __attribute__((ext_vector_type(4)));
constexpr int BM = 256, BK = 64, HALF = 128, HTB = HALF * BK * 2  , STAGE_BYTES = 8 * HTB, NXCD = 8, WGM = 8;

__host__ __device__ __forceinline__ int lds_byte(int r, int c) { const int st = (r >> 4) * 2 + (c >> 5), rr = r & 15, cc = c & 31, ob = rr * 64 + cc * 2; return st * 1024 + (ob ^ (((ob >> 9) & 1) << 5)); }
__host__ __device__ __forceinline__ void stage_rc(int b, int& R, int& C) { const int st = b / 1024, sb = b % 1024, swz = sb ^ (((sb >> 9) & 1) << 5); R = (st >> 1) * 16 + swz / 64; C = (st & 1) * 32 + (swz % 64) / 2; }
__host__ __device__ __forceinline__ int perm32(int rho) { const int n = rho >> 4, i = rho & 15; return 8 * (i >> 2) + 4 * n + (i & 3); }

struct Unit { int pm, pn; };
struct Gemm { const bf16_t* A; const bf16_t* Bt; int M, N, K; };

struct StaticOrder {
    int nM, nN, nwg, G, c;
    __host__ __device__ void init(int M, int N, int G_, int c_) { nM = M / BM; nN = N / BM; nwg = nM * nN; G = G_; c = c_; }
    __host__ __device__ bool next(int i, Unit& u) const {
        const long L = (long)i * G + c; if (L >= nwg) return false;
        int wgid = (int)L; { const int q = nwg / NXCD, r = nwg % NXCD, xcd = wgid % NXCD, off = wgid / NXCD; wgid = (xcd < r ? xcd * (q + 1) : r * (q + 1) + (xcd - r) * q) + off; }
        const int nig = WGM * nN, gid = wgid / nig, fm = gid * WGM, gsz = (nM - fm) < WGM ? (nM - fm) : WGM;
        u.pm = fm + ((wgid % nig) % gsz); u.pn = (wgid % nig) / gsz; return true;
    }
    __device__ __forceinline__ void a_ready(const Unit&) const {}
    __device__ __forceinline__ void done(const Unit&) const {}
};

__device__ __forceinline__ unsigned cvt_pk_bf16(float lo, float hi) { unsigned r; asm volatile("v_cvt_pk_bf16_f32 %0, %1, %2" : "=v"(r) : "v"(lo), "v"(hi)); return r; }
typedef float f32x2 __attribute__((ext_vector_type(2)));

#ifndef WTALL
#define WTALL 0
#endif
struct GroupOrder {
    int nM, nN, nwg, G, c;
    int t1, t2, t3, t4, t5, t6, t7;
    size_t estride;
    unsigned* hand;
    const PG8_LAS unsigned short* rl;
    __device__ __forceinline__ void init(int nM_, int N, int G_, int c_) { nM = nM_; nN = N / BM; nwg = nM * nN; G = G_; c = c_; t1 = t2 = t3 = t4 = t5 = t6 = t7 = 0x7fffffff; estride = 0; rl = nullptr; hand = nullptr; }
    __device__ __forceinline__ bool next(int i, Unit& u) const {
        const long L = (long)i * G + c; if (L >= nwg) return false;
        int wgid = (int)L; { const int q = nwg / NXCD, r = nwg % NXCD, xcd = wgid % NXCD, off = wgid / NXCD; wgid = (xcd < r ? xcd * (q + 1) : r * (q + 1) + (xcd - r) * q) + off; }
        const int nig = WGM * nN, gid = wgid / nig, fm = gid * WGM, gsz = (nM - fm) < WGM ? (nM - fm) : WGM;
        u.pm = fm + ((wgid % nig) % gsz); u.pn = (wgid % nig) / gsz; return true;
    }
    __device__ __forceinline__ const char* bbase(const Gemm& g, const Unit& u, size_t tstep) const {
        const int e = (u.pm >= t1) + (u.pm >= t2) + (u.pm >= t3) + (u.pm >= t4) + (u.pm >= t5) + (u.pm >= t6) + (u.pm >= t7);
        return (const char*)g.Bt + (size_t)e * estride + (size_t)u.pn * tstep;
    }
    __device__ __forceinline__ void a_ready(const Unit&) const {}
    __device__ __forceinline__ void done(const Unit& u) const {
        if (hand) { asm volatile("s_waitcnt vmcnt(0)" ::: "memory"); if ((threadIdx.x & 63) == 0) __hip_atomic_fetch_add(hand + 64 * u.pm, 1u, __ATOMIC_RELAXED, __HIP_MEMORY_SCOPE_AGENT); }
    }
};

typedef unsigned u32x2 __attribute__((ext_vector_type(2)));
__device__ __forceinline__ float bf_lo(unsigned w) { return __uint_as_float(w << 16); }
__device__ __forceinline__ float bf_hi(unsigned w) { return __uint_as_float(w & 0xffff0000u); }
__device__ __forceinline__ float sigmoid_f(float x) { return __builtin_amdgcn_rcpf(1.0f + __builtin_amdgcn_exp2f(-1.4426950408889634f * x)); }

struct EpiIn {
    static constexpr bool PERM = false, AFTER_DRAIN = false, ROLLOK = false; static constexpr int NST = 32;
    bf16_t* Q; bf16_t* Kb; bf16_t* VT; bf16_t* P; bf16_t* Gt; const float* rope; float c2; float us; int gate0;
    template <int ALO = 0, int AHI = 2> __device__ __forceinline__ void operator()(const f32x4 (&acc)[2][2][4][2], const Unit& u, int wr, int wc, int fr, int fq) const {
        const int row0 = u.pm * BM + wr * 64 + fr; const int pn = u.pn;
        __amdgpu_buffer_rsrc_t rsq_; if (WTALL > 1) rsq_ = __builtin_amdgcn_make_buffer_rsrc((void*)Q, 0, 0x7ffffff0, 0x00020000);
        if (pn >= 3) {
            const bool sig = pn >= gate0; bf16_t* base = sig ? Gt : P; const int ldc = sig ? 2048 : 512; const int colt = (sig ? (pn - gate0) : (pn - 3)) * 256 + wc * 32 + 4 * fq; const float cs1 = -1.4426950408889634f * us;
#pragma unroll
            for (int ai = ALO; ai < AHI; ++ai)
#pragma unroll
                for (int m = 0; m < 4; ++m) { bf16_t* rowp = base + (size_t)(row0 + ai * HALF + m * 16) * ldc + colt;
#pragma unroll
                    for (int bj = 0; bj < 2; ++bj)
#pragma unroll
                        for (int n = 0; n < 2; ++n) { f32x4 v = acc[ai][bj][m][n];
                            if (!sig) v = v * us;
                            if (sig) { const f32x4 t = v * cs1; f32x4 ex; ex[0] = __builtin_amdgcn_exp2f(t[0]); ex[1] = __builtin_amdgcn_exp2f(t[1]); ex[2] = __builtin_amdgcn_exp2f(t[2]); ex[3] = __builtin_amdgcn_exp2f(t[3]);
                                const f32x4 den = ex + 1.0f; v[0] = __builtin_amdgcn_rcpf(den[0]); v[1] = __builtin_amdgcn_rcpf(den[1]); v[2] = __builtin_amdgcn_rcpf(den[2]); v[3] = __builtin_amdgcn_rcpf(den[3]); }
                            u32x2 w; w.x = cvt_pk_bf16(v[0], v[1]); w.y = cvt_pk_bf16(v[2], v[3]); *(u32x2*)(rowp + bj * HALF + n * 16) = w; } }
        } else {
            const bool lat = u.pm < 128;
#pragma unroll
            for (int ai = ALO; ai < AHI; ++ai)
#pragma unroll
                for (int m = 0; m < 4; ++m) { const int row = row0 + ai * HALF + m * 16; const int t = row & 8191; const int pos = (wc & 1) ? (t & 63) : (t >> 6);
                    f32x4 cs = (f32x4){1.f, 1.f, 1.f, 1.f}, sn = (f32x4){0.f, 0.f, 0.f, 0.f};
                    if (lat) { cs = *(const f32x4*)(rope + pos * 32 + 4 * fq); sn = *(const f32x4*)(rope + pos * 32 + 16 + 4 * fq); }
#pragma unroll
                    for (int bj = 0; bj < 2; ++bj) { const f32x4 x1 = acc[ai][bj][m][0] * us, x2 = acc[ai][bj][m][1] * us;
                        if (pn == 2 && bj == 1) {
                            const int rc = row - 32768; const int b = lat ? (row >> 13) : (rc >> 8); const int kk = lat ? t : 8192 + (rc & 255);
                            bf16_t* vp = VT + ((size_t)((b * 2 + (wc >> 1)) * 64 + 32 * (wc & 1) + 4 * fq)) * 8448 + kk;
#pragma unroll
                            for (int j = 0; j < 4; ++j) { vp[(size_t)j * 8448] = (bf16_t)(cvt_pk_bf16(x1[j], 0.f) & 0xffffu); vp[(size_t)(16 + j) * 8448] = (bf16_t)(cvt_pk_bf16(x2[j], 0.f) & 0xffffu); }
                        } else {
                            f32x4 o1 = x1 * cs - x2 * sn, o2 = x2 * cs + x1 * sn; bf16_t* dst;
                            if (pn < 2) { o1 = o1 * c2; o2 = o2 * c2; dst = Q + (size_t)row * 512 + pn * 256 + bj * HALF + wc * 32 + 4 * fq; }
                            else dst = Kb + (size_t)row * 128 + wc * 32 + 4 * fq;
                            u32x2 w; w.x = cvt_pk_bf16(o1[0], o1[1]); w.y = cvt_pk_bf16(o1[2], o1[3]); u32x2 w2; w2.x = cvt_pk_bf16(o2[0], o2[1]); w2.y = cvt_pk_bf16(o2[2], o2[3]);
                            if (WTALL > 1 && pn < 2) { const unsigned ob = (unsigned)((const char*)dst - (const char*)Q); __builtin_amdgcn_raw_buffer_store_b64(w, rsq_, ob, 0, 16); __builtin_amdgcn_raw_buffer_store_b64(w2, rsq_, ob + 32, 0, 16); }
                            else { *(u32x2*)dst = w; *(u32x2*)(dst + 16) = w2; }
                        } } }
        }
    }
};

template <int MODE, bool WT = (WTALL != 0)> struct EpiCol8 {
    static constexpr bool PERM = true, AFTER_DRAIN = false, ROLLOK = true; static constexpr int NST = 16;
    bf16_t* O; int ldo; const bf16_t* Gt; int goff; const bf16_t* T; const float* vec; float oscale;
    template <int ALO = 0, int AHI = 2> __device__ __forceinline__ void operator()(const f32x4 (&acc)[2][2][4][2], const Unit& u, int wr, int wc, int fr, int fq) const {
        const int row0 = u.pm * BM + wr * 64 + fr, col0 = u.pn * BM + wc * 32 + 8 * fq;
        f32x4 sv[2][2];
        __amdgpu_buffer_rsrc_t rsrc_; if (WT) rsrc_ = __builtin_amdgcn_make_buffer_rsrc((void*)O, 0, 0x7ffffff0, 0x00020000);
        if (MODE == 3) {
#pragma unroll
            for (int bj = 0; bj < 2; ++bj)
#pragma unroll
                for (int n = 0; n < 2; ++n) sv[bj][n] = *(const f32x4*)(vec + col0 + bj * HALF + 4 * n);
        }
#pragma unroll
        for (int ai = ALO; ai < AHI; ++ai)
#pragma unroll
            for (int m = 0; m < 4; ++m) { const size_t row = (size_t)(row0 + ai * HALF + m * 16);
#pragma unroll
                for (int bj = 0; bj < 2; ++bj) { const int col = col0 + bj * HALF; f32x4 v0 = acc[ai][bj][m][0], v1 = acc[ai][bj][m][1];
                    if (MODE == 1 || MODE == 2) { const u32x4 g = *(const u32x4*)(Gt + row * 2048 + goff + col);
                        v0[0] *= bf_lo(g.x); v0[1] *= bf_hi(g.x); v0[2] *= bf_lo(g.y); v0[3] *= bf_hi(g.y); v1[0] *= bf_lo(g.z); v1[1] *= bf_hi(g.z); v1[2] *= bf_lo(g.w); v1[3] *= bf_hi(g.w); }
                    if (MODE == 2) { const u32x4 t = *(const u32x4*)(T + row * 1024 + col);
                        v0[0] += bf_lo(t.x); v0[1] += bf_hi(t.x); v0[2] += bf_lo(t.y); v0[3] += bf_hi(t.y); v1[0] += bf_lo(t.z); v1[1] += bf_hi(t.z); v1[2] += bf_lo(t.w); v1[3] += bf_hi(t.w); }
                    if (MODE == 3) { v0 = v0 * sv[bj][0]; v1 = v1 * sv[bj][1]; }
                    if (MODE == 0) { v0 = v0 * oscale; v1 = v1 * oscale; }
                    u32x4 w; w.x = cvt_pk_bf16(v0[0], v0[1]); w.y = cvt_pk_bf16(v0[2], v0[3]); w.z = cvt_pk_bf16(v1[0], v1[1]); w.w = cvt_pk_bf16(v1[2], v1[3]);
                    if (WT) __builtin_amdgcn_raw_buffer_store_b128(w, rsrc_, (unsigned)((row * ldo + col) * 2), 0, 16); else *(u32x4*)(O + row * ldo + col) = w; } }
    }
};

struct EpiGate8 {
    static constexpr bool PERM = true, AFTER_DRAIN = false, ROLLOK = true; static constexpr int NST = 16;
    bf16_t* Gt; float unscale;
    template <int ALO = 0, int AHI = 2> __device__ __forceinline__ void operator()(const f32x4 (&acc)[2][2][4][2], const Unit& u, int wr, int wc, int fr, int fq) const {
        const int row0 = u.pm * BM + wr * 64 + fr, col0 = u.pn * BM + wc * 32 + 8 * fq; const float c1 = -1.4426950408889634f * unscale;
#pragma unroll
        for (int ai = ALO; ai < AHI; ++ai)
#pragma unroll
            for (int m = 0; m < 4; ++m) { const size_t row = (size_t)(row0 + ai * HALF + m * 16);
#pragma unroll
                for (int bj = 0; bj < 2; ++bj) { f32x4 s[2];
#pragma unroll
                    for (int n = 0; n < 2; ++n) { const f32x4 t = acc[ai][bj][m][n] * c1; f32x4 ex; ex[0] = __builtin_amdgcn_exp2f(t[0]); ex[1] = __builtin_amdgcn_exp2f(t[1]); ex[2] = __builtin_amdgcn_exp2f(t[2]); ex[3] = __builtin_amdgcn_exp2f(t[3]);
                        const f32x4 den = ex + 1.0f; s[n][0] = __builtin_amdgcn_rcpf(den[0]); s[n][1] = __builtin_amdgcn_rcpf(den[1]); s[n][2] = __builtin_amdgcn_rcpf(den[2]); s[n][3] = __builtin_amdgcn_rcpf(den[3]); }
                    u32x4 w; w.x = cvt_pk_bf16(s[0][0], s[0][1]); w.y = cvt_pk_bf16(s[0][2], s[0][3]); w.z = cvt_pk_bf16(s[1][0], s[1][1]); w.w = cvt_pk_bf16(s[1][2], s[1][3]);
                    if (WTALL) { unsigned long long* gp = (unsigned long long*)(Gt + row * 2048 + col0 + bj * HALF);
                        __hip_atomic_store(gp, ((unsigned long long)w.y << 32) | (unsigned long long)w.x, __ATOMIC_RELAXED, __HIP_MEMORY_SCOPE_AGENT); __hip_atomic_store(gp + 1, ((unsigned long long)w.w << 32) | (unsigned long long)w.z, __ATOMIC_RELAXED, __HIP_MEMORY_SCOPE_AGENT); }
                    else *(u32x4*)(Gt + row * 2048 + col0 + bj * HALF) = w; } }
    }
};

__device__ __forceinline__ unsigned pack_fp8x4(float a, float b, float c, float d) {
    a = __builtin_amdgcn_fmed3f(a, -448.f, 448.f); b = __builtin_amdgcn_fmed3f(b, -448.f, 448.f); c = __builtin_amdgcn_fmed3f(c, -448.f, 448.f); d = __builtin_amdgcn_fmed3f(d, -448.f, 448.f);
    int r = 0; r = __builtin_amdgcn_cvt_pk_fp8_f32(a, b, r, false); r = __builtin_amdgcn_cvt_pk_fp8_f32(c, d, r, true); return (unsigned)r; }
template <bool FP8, bool FP8OUT> struct EpiSwiglu {
    static constexpr bool PERM = true, AFTER_DRAIN = false, ROLLOK = true; static constexpr int NST = 8;
    void* H; int ldh; float unscale, hscale;
    template <int ALO = 0, int AHI = 2> __device__ __forceinline__ void operator()(const f32x4 (&acc)[2][2][4][2], const Unit& u, int wr, int wc, int fr, int fq) const {
        const int row0 = u.pm * BM + wr * 64 + fr, col0 = u.pn * HALF + wc * 32 + 8 * fq;
        const float c1 = -1.4426950408889634f * (FP8 ? unscale : 1.0f), c2 = (FP8 ? unscale * unscale : 1.0f) * (FP8OUT ? hscale : 1.0f);
#pragma unroll
        for (int ai = ALO; ai < AHI; ++ai)
#pragma unroll
            for (int m = 0; m < 4; ++m) { const size_t row = (size_t)(row0 + ai * HALF + m * 16); f32x4 h[2];
#pragma unroll
                for (int n = 0; n < 2; ++n) { const f32x4 gt = acc[ai][0][m][n], up = acc[ai][1][m][n];
                    const f32x4 t = gt * c1; f32x4 ex; ex[0] = __builtin_amdgcn_exp2f(t[0]); ex[1] = __builtin_amdgcn_exp2f(t[1]); ex[2] = __builtin_amdgcn_exp2f(t[2]); ex[3] = __builtin_amdgcn_exp2f(t[3]);
                    const f32x4 den = ex + 1.0f; f32x4 r; r[0] = __builtin_amdgcn_rcpf(den[0]); r[1] = __builtin_amdgcn_rcpf(den[1]); r[2] = __builtin_amdgcn_rcpf(den[2]); r[3] = __builtin_amdgcn_rcpf(den[3]);
                    f32x4 p = gt * up; p = p * r; if (FP8 || FP8OUT) p = p * c2; h[n] = p; }
                if (FP8OUT) { u32x2 w; w.x = pack_fp8x4(h[0][0], h[0][1], h[0][2], h[0][3]); w.y = pack_fp8x4(h[1][0], h[1][1], h[1][2], h[1][3]); if (WTALL) __hip_atomic_store((unsigned long long*)((unsigned char*)H + row * ldh + col0), ((unsigned long long)w.y << 32) | (unsigned long long)w.x, __ATOMIC_RELAXED, __HIP_MEMORY_SCOPE_AGENT); else *(u32x2*)((unsigned char*)H + row * ldh + col0) = w; }
                else { u32x4 w; w.x = cvt_pk_bf16(h[0][0], h[0][1]); w.y = cvt_pk_bf16(h[0][2], h[0][3]); w.z = cvt_pk_bf16(h[1][0], h[1][1]); w.w = cvt_pk_bf16(h[1][2], h[1][3]);
                    *(u32x4*)((bf16_t*)H + row * ldh + col0) = w; } }
    }
};

template <class Epi, class Sched, bool ALIGN_EPI = false, bool SP2 = false, bool FP8 = false, bool GATHER = false>
__device__ __forceinline__ void gemm_phase(PG8_LAS unsigned char* lds, const Gemm g, const Sched& S, const Epi& E) {
    int tid_ = threadIdx.x; asm volatile("" : "+v"(tid_)); const int tid = tid_, wid = __builtin_amdgcn_readfirstlane(tid >> 6), lane = tid & 63, wr = wid >> 2, wc = wid & 3, fr = lane & 15, fq = lane >> 4;
    const int K = g.K, nt = K / BK;
    unsigned voffA[2], voffB[2]; int rowA[2]; unsigned colA2[2]; unsigned vA[2][2], vAn[2][2]; bool last_ = false; (void)rowA; (void)colA2; (void)vA; (void)vAn; (void)last_;
#pragma unroll
    for (int i = 0; i < 2; ++i) { int R, C; stage_rc(tid * 16 + i * 8192, R, C); const int Rb = Epi::PERM ? ((R & ~31) + perm32(R & 31)) : R;
        voffA[i] = (unsigned)(R * K + C) * 2u; voffB[i] = (unsigned)(Rb * K + C) * 2u; rowA[i] = R; colA2[i] = (unsigned)C * 2u; }
    const size_t kstep = (size_t)(BK * 2);
    const size_t hstep = (size_t)HALF * K * 2;
    const size_t tstep = 2 * hstep;
    const unsigned ldsw = (unsigned)wid * 1024u;
    const int aoff = lds_byte(wr * 64 + fr, fq * 8), boff = lds_byte(wc * 32 + fr, fq * 8);
#define PG8_SA(b, h) (((b) * 2 + (h)) * HTB)
#define PG8_SB(b, h) ((4 + (b) * 2 + (h)) * HTB)
#define PG8_STAGE(bufoff, gbase, voff) do { _Pragma("unroll") for (int _i = 0; _i < 2; ++_i) \
        __builtin_amdgcn_global_load_lds((const unsigned*)((const char*)(gbase) + (voff)[_i]), (PG8_LAS unsigned*)(lds + (bufoff) + ldsw + _i * 8192), 16, 0, 0); } while (0)
#define PG8_STAGE_A(bufoff, base, half, nx) do { if constexpr (GATHER) { unsigned vsel_[2]; vsel_[0] = ((nx) && last_) ? vAn[half][0] : vA[half][0]; vsel_[1] = ((nx) && last_) ? vAn[half][1] : vA[half][1]; PG8_STAGE(bufoff, base, vsel_); } \
        else { PG8_STAGE(bufoff, (base) + (half) * hstep, voffA); } } while (0)
#define PG8_LDA(dst, b, h) do { _Pragma("unroll") for (int m = 0; m < 4; ++m) { if constexpr (FP8) { const v4i_ lo_ = *(const PG8_LAS v4i_*)(lds + PG8_SA(b, h) + aoff + m * 2048), hi_ = *(const PG8_LAS v4i_*)(lds + PG8_SA(b, h) + aoff + m * 2048 + 1024); \
        dst##8[m] = __builtin_shufflevector(lo_, hi_, 0, 1, 2, 3, 4, 5, 6, 7); } else { _Pragma("unroll") for (int k = 0; k < 2; ++k) dst[m][k] = *(const PG8_LAS bf16x8*)(lds + PG8_SA(b, h) + aoff + m * 2048 + k * 1024); } } } while (0)
#define PG8_LDB(dst, b, h) do { _Pragma("unroll") for (int n = 0; n < 2; ++n) { if constexpr (FP8) { const v4i_ lo_ = *(const PG8_LAS v4i_*)(lds + PG8_SB(b, h) + boff + n * 2048), hi_ = *(const PG8_LAS v4i_*)(lds + PG8_SB(b, h) + boff + n * 2048 + 1024); \
        dst##8[n] = __builtin_shufflevector(lo_, hi_, 0, 1, 2, 3, 4, 5, 6, 7); } else { _Pragma("unroll") for (int k = 0; k < 2; ++k) dst[n][k] = *(const PG8_LAS bf16x8*)(lds + PG8_SB(b, h) + boff + n * 2048 + k * 1024); } } } while (0)
#define PG8_MMA(ai, bj, At, Bt) do { __builtin_amdgcn_s_setprio(1); _Pragma("unroll") for (int m = 0; m < 4; ++m) _Pragma("unroll") for (int n = 0; n < 2; ++n) { \
        if constexpr (FP8) { asm volatile("v_mfma_f32_16x16x128_f8f6f4 %0, %1, %2, %0" : "+v"(acc[ai][bj][m][n]) : "v"(Bt##8[n]), "v"(At##8[m])); } \
        else { _Pragma("unroll") for (int k = 0; k < 2; ++k) acc[ai][bj][m][n] = __builtin_amdgcn_mfma_f32_16x16x32_bf16(Bt[n][k], At[m][k], acc[ai][bj][m][n], 0, 0, 0); } } \
        __builtin_amdgcn_s_setprio(0); } while (0)
#define PG8_WAIT_V(n) asm volatile("s_waitcnt vmcnt(" #n ")" ::: "memory")
#define PG8_WAIT_L(n) asm volatile("s_waitcnt lgkmcnt(" #n ")" ::: "memory")
#define PG8_BAR __builtin_amdgcn_s_barrier()
#define PG8_SCHED __builtin_amdgcn_sched_barrier(0)
    Unit cur, nxt; int ui = 0;
    if (!S.next(0, cur)) return;
    f32x4 acc[2][2][4][2];
#pragma unroll
    for (int a = 0; a < 2; ++a)
#pragma unroll
        for (int b = 0; b < 2; ++b)
#pragma unroll
            for (int m = 0; m < 4; ++m)
#pragma unroll
                for (int n = 0; n < 2; ++n) acc[a][b][m][n] = (f32x4){0.f, 0.f, 0.f, 0.f};
    typedef int v4i_ __attribute__((ext_vector_type(4))); typedef int v8i_ __attribute__((ext_vector_type(8)));
    bf16x8 At[4][2], B0[2][2], B1[2][2]; v8i_ At8[4], B08[2], B18[2];
    (void)At; (void)B0; (void)B1; (void)At8; (void)B08; (void)B18;
    const char* cA = GATHER ? (const char*)g.A : (const char*)g.A + (size_t)cur.pm * tstep; const char* cB = S.bbase(g, cur, tstep);
#define PG8_ROWS(dst, uidx) do { const PG8_LAS unsigned short* rl_ = S.rl + (uidx) * 256; _Pragma("unroll") for (int h_ = 0; h_ < 2; ++h_) _Pragma("unroll") for (int i_ = 0; i_ < 2; ++i_) \
        dst[h_][i_] = (unsigned)rl_[h_ * HALF + rowA[i_]] * (unsigned)(K * 2) + colA2[i_]; } while (0)
    if constexpr (GATHER) { PG8_ROWS(vA, 0); _Pragma("unroll") for (int h_ = 0; h_ < 2; ++h_) { vAn[h_][0] = vA[h_][0]; vAn[h_][1] = vA[h_][1]; } }
    S.a_ready(cur);
    if constexpr (SP2) {
        PG8_STAGE(PG8_SB(0, 0), cB, voffB); PG8_STAGE(PG8_SB(0, 1), cB + hstep, voffB); PG8_STAGE_A(PG8_SA(0, 0), cA, 0, 0); PG8_STAGE_A(PG8_SA(0, 1), cA, 1, 0);
        if (wr == 1) PG8_BAR;
        PG8_WAIT_V(2); PG8_BAR;
        PG8_STAGE(PG8_SB(1, 0), cB + kstep, voffB); PG8_STAGE_A(PG8_SA(1, 0), cA + kstep, 0, 0); PG8_STAGE(PG8_SB(1, 1), cB + hstep + kstep, voffB);
        PG8_WAIT_V(6); PG8_BAR;
    } else {
        PG8_STAGE(PG8_SB(0, 0), cB, voffB); PG8_STAGE_A(PG8_SA(0, 0), cA, 0, 0); PG8_STAGE(PG8_SB(0, 1), cB + hstep, voffB); PG8_STAGE_A(PG8_SA(0, 1), cA, 1, 0);
        if (wr == 1) PG8_BAR;
        PG8_WAIT_V(4); PG8_BAR;
        PG8_STAGE(PG8_SB(1, 0), cB + kstep, voffB); PG8_STAGE_A(PG8_SA(1, 0), cA + kstep, 0, 0); PG8_STAGE(PG8_SB(1, 1), cB + hstep + kstep, voffB);
        PG8_WAIT_V(6); PG8_BAR;
    }
    for (;;) {
        const bool has_next = S.next(ui + 1, nxt);
        const char* nA = (has_next && !GATHER) ? (const char*)g.A + (size_t)nxt.pm * tstep : cA; const char* nB = has_next ? S.bbase(g, nxt, tstep) : cB;
        if constexpr (GATHER) { if (has_next) PG8_ROWS(vAn, ui + 1); }
        for (int t = 0; t < nt; t += 2) {
            const bool last = (t == nt - 2); last_ = last;
            const char* a1 = cA + (size_t)(t + 1) * kstep;
            const char* a2 = last ? nA : cA + (size_t)(t + 2) * kstep; const char* b2 = last ? nB : cB + (size_t)(t + 2) * kstep;
            const char* a3 = a2 + kstep; const char* b3 = b2 + kstep;
            if (last && has_next) S.a_ready(nxt);
            if constexpr (SP2) {
            PG8_LDB(B0, 0, 0); PG8_LDB(B1, 0, 1); PG8_SCHED; PG8_LDA(At, 0, 0); PG8_STAGE_A(PG8_SA(1, 1), a1, 1, 0);
            PG8_WAIT_V(8); PG8_WAIT_L(0); PG8_BAR; PG8_MMA(0, 0, At, B0); PG8_MMA(0, 1, At, B1); PG8_BAR; PG8_SCHED;
            PG8_LDA(At, 0, 1); PG8_STAGE(PG8_SB(0, 0), b2, voffB); PG8_STAGE(PG8_SB(0, 1), b2 + hstep, voffB); PG8_STAGE_A(PG8_SA(0, 0), a2, 0, 1);
            PG8_WAIT_V(8); PG8_WAIT_L(0); PG8_BAR; PG8_MMA(1, 0, At, B0); PG8_MMA(1, 1, At, B1); PG8_BAR; PG8_SCHED;
            PG8_LDB(B0, 1, 0); PG8_LDB(B1, 1, 1); PG8_SCHED; PG8_LDA(At, 1, 0); PG8_STAGE_A(PG8_SA(0, 1), a2, 1, 1);
            PG8_WAIT_V(8); PG8_WAIT_L(0); PG8_BAR; PG8_MMA(0, 0, At, B0); PG8_MMA(0, 1, At, B1); PG8_BAR; PG8_SCHED;
            PG8_LDA(At, 1, 1); PG8_STAGE(PG8_SB(1, 0), b3, voffB); PG8_STAGE(PG8_SB(1, 1), b3 + hstep, voffB); PG8_STAGE_A(PG8_SA(1, 0), a3, 0, 1);
            PG8_WAIT_V(8); PG8_WAIT_L(0); PG8_BAR; PG8_MMA(1, 0, At, B0); PG8_MMA(1, 1, At, B1); PG8_BAR; PG8_SCHED;
            } else {
            PG8_LDB(B0, 0, 0); PG8_SCHED; PG8_LDA(At, 0, 0); PG8_STAGE_A(PG8_SA(1, 1), a1, 1, 0);
            PG8_WAIT_L(8); PG8_BAR; PG8_WAIT_L(0); PG8_MMA(0, 0, At, B0); PG8_BAR; PG8_SCHED;
            PG8_LDB(B1, 0, 1); PG8_STAGE(PG8_SB(0, 0), b2, voffB);
            PG8_BAR; PG8_WAIT_L(0); PG8_MMA(0, 1, At, B1); PG8_BAR;
            PG8_LDA(At, 0, 1); PG8_STAGE_A(PG8_SA(0, 0), a2, 0, 1);
            PG8_BAR; PG8_WAIT_L(0); PG8_MMA(1, 0, At, B0); PG8_BAR; PG8_SCHED;
            PG8_STAGE(PG8_SB(0, 1), b2 + hstep, voffB);
            PG8_WAIT_V(6); PG8_BAR; PG8_MMA(1, 1, At, B1); PG8_BAR;
            PG8_LDB(B0, 1, 0); PG8_SCHED; PG8_LDA(At, 1, 0); PG8_STAGE_A(PG8_SA(0, 1), a2, 1, 1);
            PG8_WAIT_L(8); PG8_BAR; PG8_WAIT_L(0); PG8_MMA(0, 0, At, B0); PG8_BAR; PG8_SCHED;
            PG8_LDB(B1, 1, 1); PG8_STAGE(PG8_SB(1, 0), b3, voffB);
            PG8_BAR; PG8_WAIT_L(0); PG8_MMA(0, 1, At, B1); PG8_BAR;
            PG8_LDA(At, 1, 1); PG8_STAGE_A(PG8_SA(1, 0), a3, 0, 1);
            PG8_BAR; PG8_WAIT_L(0); PG8_MMA(1, 0, At, B0); PG8_BAR; PG8_SCHED;
            PG8_STAGE(PG8_SB(1, 1), b3 + hstep, voffB);
            PG8_WAIT_V(6); PG8_BAR; PG8_MMA(1, 1, At, B1); PG8_BAR;
            }
        }
        if constexpr (FP8) asm volatile("s_nop 15\n\ts_nop 7" : "+v"(acc[1][1][0][0]), "+v"(acc[1][1][0][1]), "+v"(acc[1][1][1][0]), "+v"(acc[1][1][1][1]), "+v"(acc[1][1][2][0]), "+v"(acc[1][1][2][1]), "+v"(acc[1][1][3][0]), "+v"(acc[1][1][3][1]));
        if constexpr (ALIGN_EPI) { if (wr == 0) PG8_BAR; }
        if constexpr (!Epi::AFTER_DRAIN) { E(acc, cur, wr, wc, fr, fq); S.done(cur); }
        if (!has_next) break;
#pragma unroll
        for (int a = 0; a < 2; ++a)
#pragma unroll
            for (int b = 0; b < 2; ++b)
#pragma unroll
                for (int m = 0; m < 4; ++m)
#pragma unroll
                    for (int n = 0; n < 2; ++n) acc[a][b][m][n] = (f32x4){0.f, 0.f, 0.f, 0.f};
        cur = nxt; cA = nA; cB = nB; ++ui;
        if constexpr (GATHER) { _Pragma("unroll") for (int h_ = 0; h_ < 2; ++h_) { vA[h_][0] = vAn[h_][0]; vA[h_][1] = vAn[h_][1]; } }
        if constexpr (ALIGN_EPI) { if (wr == 1) PG8_BAR; }
    }
    PG8_WAIT_V(0);
    if constexpr (!ALIGN_EPI) { if (wr == 0) PG8_BAR; }
    PG8_BAR;
    if constexpr (Epi::AFTER_DRAIN) { E.fused(acc, cur, wr, wc, fr, fq, lds, wid, lane); S.done(cur); }
#undef PG8_SA
#undef PG8_SB
#undef PG8_STAGE
#undef PG8_STAGE_A
#undef PG8_ROWS
#undef PG8_LDA
#undef PG8_LDB
#undef PG8_MMA
#undef PG8_WAIT_V
#undef PG8_WAIT_L
#undef PG8_BAR
#undef PG8_SCHED
}
}

constexpr int D = 1024, SEQ = 8192, DEPTH = 4, CTXL = 256;
constexpr int M_LAT = 32768, M_CTX = 1024, M = M_LAT + M_CTX;
constexpr int INW = 3328, DFF = 2816, NEXP = 8, DFFE = 3584;
constexpr int MP = 69632;
constexpr int VTP = SEQ + CTXL;
constexpr float EPS = 1e-6f;
constexpr float C2 = 0.125f * 1.4426950408889634f;
#ifndef FP8MASK
#define FP8MASK 0xF
#endif
constexpr float WSC = 128.f, ASC = 16.f, HSC = 8.f;
#ifndef FP8DN
#define FP8DN 0xF
#endif
__host__ __device__ constexpr bool gu_fp8(int l) { return ((FP8MASK >> l) & 1) != 0; }
__host__ __device__ constexpr bool dn_fp8(int l) { return ((FP8DN >> l) & 1) != 0; }
constexpr bool any_combo(bool gi, bool dn) { return (gu_fp8(0) == gi && dn_fp8(0) == dn) || (gu_fp8(1) == gi && dn_fp8(1) == dn) || (gu_fp8(2) == gi && dn_fp8(2) == dn) || (gu_fp8(3) == gi && dn_fp8(3) == dn); }
constexpr int NPH = 1 + 11 * DEPTH;

constexpr size_t MiB = 1u << 20;
constexpr size_t WS_CTL = 0, CTL_ZERO_BYTES = 1 * MiB;
constexpr size_t WS_MOD = 1 * MiB;
constexpr size_t WS_ROPE = 1 * MiB + 512 * 1024;
constexpr size_t WS_TOKSLOT = 2 * MiB;
constexpr size_t WS_TOKW = 2 * MiB + 512 * 1024;
constexpr size_t WS_LIST = 3 * MiB;
constexpr size_t WS_CTXS = 5 * MiB;
constexpr size_t WS_WIN = 9 * MiB, WS_WAO = 35 * MiB, WS_WPM = 39 * MiB, WS_WPO = 41 * MiB, WS_WOUT = 45 * MiB, WS_WGU = 53 * MiB, WS_WDN = 75 * MiB, WS_WEGU = 86 * MiB, WS_WEDN = 198 * MiB;
constexpr size_t WS_W8GU = 254 * MiB, WS_W8DN = 265 * MiB;
constexpr size_t WS_XN = 271 * MiB;
#ifndef XBF16
#define XBF16 1
#endif
constexpr size_t WS_XB = 337 * MiB;
constexpr size_t WS_AR = (XBF16 ? 403 : 337) * MiB;
constexpr size_t AR_Q = 0, AR_K = 33 * MiB, AR_VT = AR_K + 8 * MiB + 256 * 1024, AR_P = AR_VT + 8 * MiB + 256 * 1024, AR_G = AR_P + 33 * MiB, AR_ATT = AR_G + 132 * MiB, AR_POOLED = AR_ATT + 33 * MiB,
                 AR_MIX = AR_POOLED + 33 * MiB, AR_T1 = AR_MIX + 33 * MiB, AR_MERGED = AR_T1 + 66 * MiB, AR_Y = AR_MERGED + 66 * MiB;
#ifndef GATE8
#define GATE8 1
#endif
#ifndef QKV8
#define QKV8 1
#endif
static_assert(!QKV8 || GATE8, "QKV8 builds on the fp8 gate-logit GEMM");
#ifndef PF8
#define PF8 0
#endif
static_assert(!PF8 || QKV8, "PF8 builds on QKV8");
#ifndef CONV0_TAIL
#define CONV0_TAIL 0
#endif
#ifndef QKV1
#define QKV1 0
#endif
constexpr int NQKVP = 1280;
constexpr size_t AR_XN8 = 520 * MiB;
constexpr size_t AR_XF = 0;
constexpr size_t AR_XG = 0, AR_HID = 136 * MiB;
constexpr size_t WS_END = WS_AR + 612 * MiB;
static_assert(AR_XN8 + (size_t)M * D <= 612 * MiB && AR_XN8 >= AR_Y + 66 * MiB && AR_HID + (size_t)M * DFF * 2 <= AR_XN8 && (!GATE8 || (dn_fp8(1) && dn_fp8(3))), "XN8 placement");
static_assert(AR_Y + 66 * MiB <= 612 * MiB && AR_HID + (size_t)MP * DFFE * 2 <= 612 * MiB && (size_t)MP * D * 2 <= AR_HID, "arena");
static_assert(WS_WIN + (size_t)4 * INW * D * 2 <= WS_WAO && WS_WGU + (size_t)2 * 2 * DFF * D * 2 <= WS_WDN && WS_WDN + (size_t)2 * DFF * D * 2 <= WS_WEGU &&
              WS_WEGU + (size_t)8 * 2 * DFFE * D * 2 <= WS_WEDN && WS_WEDN + (size_t)8 * DFFE * D * 2 <= WS_W8GU && WS_W8GU + (size_t)2 * 2 * DFF * D <= WS_W8DN && WS_W8DN + (size_t)2 * DFF * D <= WS_XN && WS_XN + (size_t)M * D * 2 <= WS_AR && AR_XF + (size_t)M * D * 2 <= AR_HID, "ws map");
constexpr int CW_BAR = 4096;
constexpr int CW_HAND = 32768, HAND_BANK = 132 * 64;
constexpr int CW_FILL = 16384;
constexpr int RING_BYTES = 131072, LDSCTL_OFF = RING_BYTES, MISC_OFF = LDSCTL_OFF + 320, RL_OFF = LDSCTL_OFF + 1024, RL_UNITS = 30, LDS_BYTES = 147456;
static_assert(RL_OFF + RL_UNITS * 512 <= LDS_BYTES, "LDS map");
constexpr int NWAVES = 8;

#define GAS __attribute__((address_space(1)))
#define LAS __attribute__((address_space(3)))
typedef unsigned short bf16;
typedef unsigned v4u __attribute__((ext_vector_type(4)));
typedef unsigned v2u __attribute__((ext_vector_type(2)));
typedef float f32x4 __attribute__((ext_vector_type(4)));
typedef float f32x2 __attribute__((ext_vector_type(2)));
typedef float f32x16 __attribute__((ext_vector_type(16)));
typedef short bf16x8 __attribute__((ext_vector_type(8)));
typedef short s16x4 __attribute__((ext_vector_type(4)));
typedef GAS unsigned gu32;
#define RLX_AGENT __ATOMIC_RELAXED, __HIP_MEMORY_SCOPE_AGENT
#define LDS_WAIT() asm volatile("s_waitcnt lgkmcnt(0)" ::: "memory")
#define VM_WAIT() asm volatile("s_waitcnt vmcnt(0)" ::: "memory")
__device__ __forceinline__ unsigned pk2(float lo, float hi) { return pg8::cvt_pk_bf16(lo, hi); }
__device__ __forceinline__ float bflo(unsigned w) { return __uint_as_float(w << 16); }
__device__ __forceinline__ float bfhi(unsigned w) { return __uint_as_float(w & 0xffff0000u); }
__device__ __forceinline__ float fast_exp(float x) { return __builtin_amdgcn_exp2f(1.4426950408889634f * x); }

#define XB_TMO      128
#define XB_XCNT(j)  (256  + 64 * (j))
#define XB_XSUB(j)  (1280 + 64 * (j))
#define XB_XGEN(j)  (2304 + 64 * (j))
#define XB_TOP      3328
#define XB_TOPGEN   3392
#define XCD_BAR_WORDS 3456
#define XB_SPIN_CAP (1u << 18)

__device__ __forceinline__ unsigned xb_ld(unsigned* p)              { return __hip_atomic_load(p, __ATOMIC_RELAXED, __HIP_MEMORY_SCOPE_AGENT); }
__device__ __forceinline__ unsigned xb_add(unsigned* p, unsigned v) { return __hip_atomic_fetch_add(p, v, __ATOMIC_RELAXED, __HIP_MEMORY_SCOPE_AGENT); }
__device__ __forceinline__ unsigned xb_xcc_id() { return (unsigned)__builtin_amdgcn_s_getreg((3 << 11) | 20) & 0xFu; }
#define XB_SPIN(cond, bar) do { unsigned _sp = 0; while (cond) { __builtin_amdgcn_s_sleep(1); \
    if ((++_sp & 255u) == 0u) { if (xb_ld(&(bar)[XB_TMO])) break; if (_sp > XB_SPIN_CAP) { atomicAdd(&(bar)[XB_TMO], 1u); break; } } } } while (0)

struct XcdBarrier {
    unsigned* bar; unsigned x;
    volatile LAS unsigned* st;
};

__device__ __forceinline__ XcdBarrier xcd_barrier_post(unsigned* bar, volatile LAS unsigned* st) {
    XcdBarrier b; b.bar = bar; b.x = xb_xcc_id(); b.st = st;
    if (threadIdx.x == 0) (void)xb_add(&bar[XB_XCNT(b.x)], 1u);
    return b;
}
__device__ __forceinline__ void xcd_barrier_complete(unsigned* bar, unsigned x, unsigned& nloc, unsigned& nx) {
    const unsigned G = gridDim.x * gridDim.y * gridDim.z;
    unsigned sum, cnt, mine, sp = 0u;
    for (;;) {
        sum = 0u; cnt = 0u; mine = 0u;
#pragma unroll
        for (unsigned j = 0; j < 16; ++j) { const unsigned c = xb_ld(&bar[XB_XCNT(j)]); sum += c; cnt += (c > 0u) ? 1u : 0u; mine = (j == x) ? c : mine; }
        if (sum == G) break;
        __builtin_amdgcn_s_sleep(1);
        if ((++sp & 255u) == 0u) { if (xb_ld(&bar[XB_TMO])) break; if (sp > XB_SPIN_CAP) { atomicAdd(&bar[XB_TMO], 1u); break; } }
    }
    nloc = mine > 0u ? mine : 1u; nx = cnt > 0u ? cnt : 1u;
}

__device__ __forceinline__ void xcd_barrier(const XcdBarrier& b) {
    asm volatile("s_waitcnt vmcnt(0)" ::: "memory");
    __syncthreads();
    if (threadIdx.x == 0) {
        unsigned* bar = b.bar;
        __builtin_amdgcn_s_waitcnt(0);
        unsigned nloc = b.st[0], nx = b.st[1];
        if (nloc == 0u) { xcd_barrier_complete(bar, b.x, nloc, nx); b.st[0] = nloc; b.st[1] = nx; }
        const unsigned old = xb_add(&bar[XB_XSUB(b.x)], 1u);
        const unsigned gen = old / nloc;
        if (old + 1u == (gen + 1u) * nloc) {
            __builtin_amdgcn_fence(__ATOMIC_RELEASE, "agent");
            asm volatile("s_waitcnt vmcnt(0)" ::: "memory");
            const unsigned og = xb_add(&bar[XB_TOP], 1u);
            const unsigned tg = og / nx;
            if (og + 1u == (tg + 1u) * nx) xb_add(&bar[XB_TOPGEN], 1u);
            else XB_SPIN(xb_ld(&bar[XB_TOPGEN]) == tg, bar);
            __builtin_amdgcn_fence(__ATOMIC_ACQUIRE, "agent");
            xb_add(&bar[XB_XGEN(b.x)], 1u);
            asm volatile("s_waitcnt vmcnt(0)" ::: "memory");
        } else {
            XB_SPIN(xb_ld(&bar[XB_XGEN(b.x)]) == gen, bar);
            __builtin_amdgcn_fence(__ATOMIC_ACQUIRE, "agent");
            asm volatile("s_waitcnt vmcnt(0)" ::: "memory");
        }
    }
    __syncthreads();
}

struct Frame {
    LAS unsigned char* lds;
    volatile LAS unsigned* MISC;
    gu32* ctl;
    unsigned char* ws;
    int tid, lane, wave, vcu, G;
};
template <int CTRL> __device__ __forceinline__ float dpp_f(float v) { return __builtin_bit_cast(float, __builtin_amdgcn_update_dpp(0, __builtin_bit_cast(int, v), CTRL, 0xF, 0xF, true)); }
__device__ __forceinline__ float wave_sum(float v) {
    v += dpp_f<0xB1>(v); v += dpp_f<0x4E>(v); v += dpp_f<0x141>(v); v += dpp_f<0x140>(v);
    { auto r = __builtin_amdgcn_permlane16_swap(__float_as_uint(v), __float_as_uint(v), false, false); v = __uint_as_float(r[0]) + __uint_as_float(r[1]); }
    { auto r = __builtin_amdgcn_permlane32_swap(__float_as_uint(v), __float_as_uint(v), false, false); v = __uint_as_float(r[0]) + __uint_as_float(r[1]); }
    return v;
}

__device__ __forceinline__ void transpose_item(const float* W, int N, int K, int k0, int n0, bf16* dst0, LAS float* scr_, int lane) {
    LAS unsigned* scr = (LAS unsigned*)scr_;
    const int n4 = (lane & 15) * 4, kq = lane >> 4;
    const float* src = W + (size_t)(k0 + 2 * kq) * N + n0 + n4;
    f32x4 a[8], b[8];
#pragma unroll
    for (int i = 0; i < 8; ++i) { a[i] = *(const f32x4*)(src + (size_t)(8 * i) * N); b[i] = *(const f32x4*)(src + (size_t)(8 * i + 1) * N); }
#pragma unroll
    for (int i = 0; i < 8; ++i) { LAS unsigned* d = scr + n4 * 33 + 4 * i + kq;
        d[0] = pk2(a[i].x, b[i].x); d[33] = pk2(a[i].y, b[i].y); d[66] = pk2(a[i].z, b[i].z); d[99] = pk2(a[i].w, b[i].w); }
    LDS_WAIT(); asm volatile("" ::: "memory");
    const int c = lane & 7;
#pragma unroll
    for (int j = 0; j < 8; ++j) { const int n = (lane >> 3) + 8 * j; const LAS unsigned* sp = scr + n * 33 + 4 * c;
        v4u o; o.x = sp[0]; o.y = sp[1]; o.z = sp[2]; o.w = sp[3];
        *(GAS v4u*)(dst0 + (size_t)n * K + k0 + 8 * c) = o; }
    LDS_WAIT(); asm volatile("" ::: "memory");
}
__device__ __forceinline__ void conv_plain(const float* W, int K, int N, bf16* WT, int item, LAS float* scr, int lane) {
    const int nblk = N / 64, kb = item / nblk, nb = item % nblk;
    transpose_item(W, N, K, 64 * kb, 64 * nb, WT + (size_t)(64 * nb) * K, scr, lane);
}
__device__ __forceinline__ void conv_gu(const float* W, int K, int N, bf16* WT, int up, int item, LAS float* scr, int lane) {
    const int nblk = N / 64, kb = item / nblk, nb = item % nblk, n0 = 64 * nb;
    transpose_item(W, N, K, 64 * kb, n0, WT + (size_t)((n0 >> 7) * 256 + up * 128 + (n0 & 127)) * K, scr, lane);
}
__device__ __forceinline__ unsigned fp8x4(float a, float b, float c, float d) { int r = 0; r = __builtin_amdgcn_cvt_pk_fp8_f32(a, b, r, false); r = __builtin_amdgcn_cvt_pk_fp8_f32(c, d, r, true); return (unsigned)r; }
__device__ __forceinline__ void transpose_item8(const float* W, int N, int K, int k0, int n0, unsigned char* dst0, float sc, LAS float* scr_, int lane) {
    LAS unsigned* scr = (LAS unsigned*)scr_;
    const int n4 = (lane & 15) * 4, kq = lane >> 4;
    const float* src = W + (size_t)(k0 + 4 * kq) * N + n0 + n4;
    f32x4 a[4][4];
#pragma unroll
    for (int i = 0; i < 4; ++i)
#pragma unroll
        for (int q = 0; q < 4; ++q) a[i][q] = *(const f32x4*)(src + (size_t)(16 * i + q) * N) * sc;
#pragma unroll
    for (int i = 0; i < 4; ++i) { LAS unsigned* d = scr + n4 * 17 + 4 * i + kq;
        d[0] = fp8x4(a[i][0].x, a[i][1].x, a[i][2].x, a[i][3].x); d[17] = fp8x4(a[i][0].y, a[i][1].y, a[i][2].y, a[i][3].y);
        d[34] = fp8x4(a[i][0].z, a[i][1].z, a[i][2].z, a[i][3].z); d[51] = fp8x4(a[i][0].w, a[i][1].w, a[i][2].w, a[i][3].w); }
    LDS_WAIT(); asm volatile("" ::: "memory");
    const int c = lane & 3;
#pragma unroll
    for (int j = 0; j < 4; ++j) { const int n = (lane >> 2) + 16 * j; const LAS unsigned* sp = scr + n * 17 + 4 * c;
        v4u o; o.x = sp[0]; o.y = sp[1]; o.z = sp[2]; o.w = sp[3];
        *(GAS v4u*)(dst0 + (size_t)n * K + k0 + 16 * c) = o; }
    LDS_WAIT(); asm volatile("" ::: "memory");
}
__device__ __forceinline__ void conv_plain8(const float* W, int K, int N, unsigned char* WT, int item, LAS float* scr, int lane) {
    const int nblk = N / 64, kb = item / nblk, nb = item % nblk;
    transpose_item8(W, N, K, 64 * kb, 64 * nb, WT + (size_t)(64 * nb) * K, WSC, scr, lane);
}
__device__ __forceinline__ void conv_gu8(const float* W, int K, int N, unsigned char* WT, int up, int item, LAS float* scr, int lane) {
    const int nblk = N / 64, kb = item / nblk, nb = item % nblk, n0 = 64 * nb;
    transpose_item8(W, N, K, 64 * kb, n0, WT + (size_t)((n0 >> 7) * 256 + up * 128 + (n0 & 127)) * K, WSC, scr, lane);
}
constexpr int IT_EG = (D / 64) * (DFFE / 64), IT_ED = (DFFE / 64) * (D / 64), IT_EXP_LAYER = NEXP * (2 * IT_EG + IT_ED);
__device__ __forceinline__ void conv_expert_item(const float* const* in, unsigned char* ws, int i, int it, LAS float* scr, int lane) {
    const int e = it / (2 * IT_EG + IT_ED); int r = it % (2 * IT_EG + IT_ED);
    const size_t eo = (size_t)(i * NEXP + e) * D * DFFE;
    bf16* gu = (bf16*)(ws + WS_WEGU) + (size_t)e * 2 * DFFE * D; bf16* dn = (bf16*)(ws + WS_WEDN) + (size_t)e * D * DFFE;
    const bool g8 = (i == 0) ? gu_fp8(1) : gu_fp8(3), d8 = (i == 0) ? dn_fp8(1) : dn_fp8(3);
    unsigned char* gu8 = ws + WS_WEGU + (size_t)e * 2 * DFFE * D; unsigned char* dn8 = ws + WS_WEDN + (size_t)e * D * DFFE;
    if (r < IT_EG) { if (g8) conv_gu8(in[19] + eo, D, DFFE, gu8, 0, r, scr, lane); else conv_gu(in[19] + eo, D, DFFE, gu, 0, r, scr, lane); return; } r -= IT_EG;
    if (r < IT_EG) { if (g8) conv_gu8(in[20] + eo, D, DFFE, gu8, 1, r, scr, lane); else conv_gu(in[20] + eo, D, DFFE, gu, 1, r, scr, lane); return; } r -= IT_EG;
    if (d8) conv_plain8(in[21] + eo, DFFE, D, dn8, r, scr, lane); else conv_plain(in[21] + eo, DFFE, D, dn, r, scr, lane);
}
__device__ __forceinline__ void conv_experts(Frame& F, const float* const* in, int i, int wg0 = 0, int nwg = 0) {
    int tid = F.tid; asm volatile("" : "+v"(tid)); const int lane = tid & 63; const int wave = __builtin_amdgcn_readfirstlane(tid >> 6); (void)lane; (void)wave;

    LAS float* scr = (LAS float*)(F.lds + wave * 16384);
    int gw = F.vcu * NWAVES + wave, NGW = F.G * NWAVES;
    if (nwg > 0) { const int r = (int)blockIdx.x - wg0; if (r < 0 || r >= nwg) return; gw = r * NWAVES + wave; NGW = nwg * NWAVES; }
    for (int it = gw; it < IT_EXP_LAYER; it += NGW) conv_expert_item(in, F.ws, i, it, scr, lane);
}
constexpr int IT_IN = (D / 64) * (INW / 64), IT_AO = (512 / 64) * (D / 64), IT_OUT = (D / 64) * (D / 64), IT_G = (D / 64) * (DFF / 64), IT_DN = (DFF / 64) * (D / 64);
constexpr int IT_DENSE = 4 * IT_IN + 4 * IT_AO + 4 * IT_OUT + 2 * (2 * IT_G + IT_DN);

__device__ __forceinline__ void p0_prologue(Frame& F, const float* const* in) {
    int tid = F.tid; asm volatile("" : "+v"(tid)); const int lane = tid & 63; const int wave = __builtin_amdgcn_readfirstlane(tid >> 6); (void)lane; (void)wave;

    unsigned char* ws = F.ws;
    {
        LAS float* sv = (LAS float*)F.lds;
        LAS float* red = (LAS float*)(F.lds + 20480);
        if (F.vcu < 192) {
            for (int idx = tid; idx < 5 * 1024; idx += 512) { const int r = idx >> 10, k = idx & 1023; const float v = r < 4 ? in[1][r * 1024 + k] : in[3][k]; sv[idx] = v * __builtin_amdgcn_rcpf(1.0f + fast_exp(-v)); }
            __syncthreads();
        }
        for (int it = F.vcu; it < 192; it += F.G) {
            const int l = it / 48, chunk = it % 48, col = chunk * 128 + 2 * lane;
            const float* W = in[4] + (size_t)l * D * 6144 + col;
            float a0[5], a1[5];
#pragma unroll
            for (int r = 0; r < 5; ++r) { a0[r] = 0.f; a1[r] = 0.f; }
            const int kb = wave * 128;
#pragma unroll 8
            for (int kk = 0; kk < 128; ++kk) { const int k = kb + kk; const f32x2 w = *(const f32x2*)(W + (size_t)k * 6144);
#pragma unroll
                for (int r = 0; r < 5; ++r) { const float s = sv[r * 1024 + k]; a0[r] += s * w.x; a1[r] += s * w.y; } }
#pragma unroll
            for (int r = 0; r < 5; ++r) { red[(wave * 5 + r) * 128 + 2 * lane] = a0[r]; red[(wave * 5 + r) * 128 + 2 * lane + 1] = a1[r]; }
            __syncthreads();
            for (int idx = tid; idx < 640; idx += 512) { const int r = idx >> 7, cc = idx & 127; float s = in[5][l * 6144 + chunk * 128 + cc];
#pragma unroll
                for (int w = 0; w < 8; ++w) s += red[(w * 5 + r) * 128 + cc];
                ((float*)(ws + WS_MOD))[(size_t)(l * 5 + r) * 6144 + chunk * 128 + cc] = s; }
            __syncthreads();
        }
        if (F.vcu == F.G - 1) {
            for (int idx = tid; idx < 2048; idx += 512) { const int pos = idx >> 4, i = idx & 15;
                const float freq = __builtin_amdgcn_exp2f(-(float)i * (13.287712379549449f / 16.0f)); const float ang = (float)pos * freq;
                double rev = (double)ang * 0.15915494309189535; rev -= (double)(long long)rev; const float rf = (float)rev;
                ((float*)(ws + WS_ROPE))[pos * 32 + i] = __builtin_amdgcn_cosf(rf); ((float*)(ws + WS_ROPE))[pos * 32 + 16 + i] = __builtin_amdgcn_sinf(rf); }
        }
        {
            const int gt = F.vcu * 512 + tid, NT = F.G * 512;
            for (int idx = gt; idx < 4 * 4 * 16 * 1024; idx += NT) { const int n = idx & 1023; const int ub = __builtin_amdgcn_readfirstlane(idx >> 10); const int kb = ub & 15, g = (ub >> 4) & 3, l = ub >> 6;
                const float* pw = in[10] + ((size_t)(l * 4 + g) * 128 + kb * 8) * 128; const float* ps = in[11] + l * 512 + 128 * g; const float* wp = in[12] + ((size_t)l * 512 + 128 * g) * 1024 + n;
                float acc[8];
#pragma unroll
                for (int i = 0; i < 8; ++i) acc[i] = 0.f;
#pragma unroll 16
                for (int c = 0; c < 128; ++c) { const float v = ps[c] * wp[(size_t)c * 1024];
#pragma unroll
                    for (int i = 0; i < 8; ++i) acc[i] += pw[i * 128 + c] * v; }
                v4u o; o.x = pk2(acc[0], acc[1]); o.y = pk2(acc[2], acc[3]); o.z = pk2(acc[4], acc[5]); o.w = pk2(acc[6], acc[7]);
                *(v4u*)((bf16*)(ws + WS_WPO) + (size_t)l * 1024 * 512 + (size_t)n * 512 + 128 * g + kb * 8) = o; }
        }
        __syncthreads();
    }
    LAS float* scr = (LAS float*)(F.lds + wave * 16384);
    const int gw = F.vcu * NWAVES + wave, NGW = F.G * NWAVES;
    for (int it = gw; it < IT_DENSE; it += NGW) {
        int r = it;
        if (r < 4 * IT_IN) { const int l = r / IT_IN, it2 = r % IT_IN; const int nblk = INW / 64, kb = it2 / nblk, nb = it2 % nblk;
            const float* Wl = in[7] + (size_t)l * D * INW; unsigned char* slot = ws + WS_WIN + (size_t)l * INW * D * 2;
            if (PF8) transpose_item8(Wl, INW, D, 64 * kb, 64 * nb, slot + (size_t)(64 * nb) * D, WSC, scr, lane);
            else if (QKV8) {
                const int n0 = 64 * nb;
                if (n0 >= 768 && n0 < NQKVP) transpose_item(Wl, INW, D, 64 * kb, n0, (bf16*)(slot + 3 * MiB) + (size_t)(n0 - 768) * D, scr, lane);
                else transpose_item8(Wl, INW, D, 64 * kb, n0, slot + (size_t)(n0 < 768 ? n0 : n0 - 512) * D, WSC, scr, lane);
            }
            else if (GATE8 && 64 * nb >= NQKVP) transpose_item8(Wl, INW, D, 64 * kb, 64 * nb, slot + (size_t)NQKVP * D * 2 + (size_t)(64 * nb - NQKVP) * D, WSC, scr, lane);
            else conv_plain(Wl, D, INW, (bf16*)slot, it2, scr, lane);
            continue; } r -= 4 * IT_IN;
        if (r < 4 * IT_AO) { const int l = r / IT_AO; conv_plain(in[9] + (size_t)l * 512 * D, 512, D, (bf16*)(ws + WS_WAO) + (size_t)l * D * 512, r % IT_AO, scr, lane); continue; } r -= 4 * IT_AO;
        if (r < 4 * IT_OUT) { const int l = r / IT_OUT; conv_plain(in[13] + (size_t)l * D * D, D, D, (bf16*)(ws + WS_WOUT) + (size_t)l * D * D, r % IT_OUT, scr, lane); continue; } r -= 4 * IT_OUT;
        const int i = r / (2 * IT_G + IT_DN); r = r % (2 * IT_G + IT_DN);
        bf16* gu = (bf16*)(ws + WS_WGU) + (size_t)i * 2 * DFF * D; bf16* dn = (bf16*)(ws + WS_WDN) + (size_t)i * D * DFF;
        { unsigned char* gu8 = ws + WS_W8GU + (size_t)i * 2 * DFF * D; unsigned char* dn8 = ws + WS_W8DN + (size_t)i * D * DFF; const bool g8 = gu_fp8(2 * i), d8 = dn_fp8(2 * i);
          if (r < IT_G) { if (g8) conv_gu8(in[14] + (size_t)i * D * DFF, D, DFF, gu8, 0, r, scr, lane); else conv_gu(in[14] + (size_t)i * D * DFF, D, DFF, gu, 0, r, scr, lane); continue; } r -= IT_G;
          if (r < IT_G) { if (g8) conv_gu8(in[15] + (size_t)i * D * DFF, D, DFF, gu8, 1, r, scr, lane); else conv_gu(in[15] + (size_t)i * D * DFF, D, DFF, gu, 1, r, scr, lane); continue; } r -= IT_G;
          if (d8) { conv_plain8(in[16] + (size_t)i * DFF * D, DFF, D, dn8, r, scr, lane); continue; } }
        conv_plain(in[16] + (size_t)i * DFF * D, DFF, D, dn, r, scr, lane);
    }
    if (!CONV0_TAIL) conv_experts(F, in, 0);
}

__device__ __forceinline__ const float* xrow_ptr(const float* lat, const float* ctx, int m) { return m < M_LAT ? lat + (size_t)m * D : ctx + (size_t)(m - M_LAT) * D; }
__device__ __forceinline__ float* xrow_ptr(float* lat, float* ctx, int m) { return m < M_LAT ? lat + (size_t)m * D : ctx + (size_t)(m - M_LAT) * D; }
__device__ __forceinline__ int mod_row(int m) { return m < M_LAT ? (m >> 13) : 4; }

__device__ __forceinline__ void load_row_f32(const float* p, f32x4 (&v)[4], int lane) {
#pragma unroll
    for (int j = 0; j < 4; ++j) v[j] = *(const f32x4*)(p + 256 * j + 4 * lane);
}
__device__ __forceinline__ void load_row_bf16(const bf16* p, f32x4 (&v)[4], int lane) {
#pragma unroll
    for (int j = 0; j < 4; ++j) { const v2u w = *(const v2u*)(p + 256 * j + 4 * lane); v[j] = (f32x4){bflo(w.x), bfhi(w.x), bflo(w.y), bfhi(w.y)}; }
}
__device__ __forceinline__ float row_rstd(const f32x4 (&v)[4]) {
    float ss = 0.f;
#pragma unroll
    for (int j = 0; j < 4; ++j) ss += (v[j].x * v[j].x + v[j].y * v[j].y) + (v[j].z * v[j].z + v[j].w * v[j].w);
    return __builtin_amdgcn_rsqf(wave_sum(ss) * (1.0f / D) + EPS);
}
__device__ __forceinline__ void norm_mod_store(const f32x4 (&v)[4], const f32x4 (&b1)[4], const f32x4 (&b2)[4], bf16* orow, int lane, bool valid, unsigned char* orow8 = nullptr) {
    const float rstd = row_rstd(v);
#pragma unroll
    for (int j = 0; j < 4; ++j) { const f32x4 h = (v[j] * rstd) * b1[j] + b2[j]; v2u w; w.x = pk2(h.x, h.y); w.y = pk2(h.z, h.w); if (valid) { if (!PF8) *(v2u*)(orow + 256 * j + 4 * lane) = w;
        if (GATE8 && orow8) *(unsigned*)(orow8 + 256 * j + 4 * lane) = pg8::pack_fp8x4(h.x * ASC, h.y * ASC, h.z * ASC, h.w * ASC); } }
}
struct RowDeal { int gwL, nwL, gwC, nwC; };
__device__ __forceinline__ RowDeal row_deal(const Frame& F, int wave, int nl) {
    RowDeal d;
    if (nl <= 0) { d.gwL = d.gwC = F.vcu * NWAVES + wave; d.nwL = d.nwC = F.G * NWAVES; }
    else { const int bx = (int)blockIdx.x; if (bx < nl) { d.gwL = -1; d.nwL = 1; d.gwC = bx * NWAVES + wave; d.nwC = nl * NWAVES; } else { d.gwL = (bx - nl) * NWAVES + wave; d.nwL = (F.G - nl) * NWAVES; d.gwC = -1; d.nwC = 1; } }
    return d;
}
__device__ __forceinline__ void wave_rows(const RowDeal& d, int seg, int& lo, int& hi) {
    if (seg == 0) { if (d.gwL < 0) { lo = hi = 0; return; } const int rpw = (M_LAT + d.nwL - 1) / d.nwL; lo = d.gwL * rpw; hi = lo + rpw < M_LAT ? lo + rpw : M_LAT; }
    else { if (d.gwC < 0) { lo = hi = 0; return; } const int rpw = (M_CTX + d.nwC - 1) / d.nwC; lo = M_LAT + d.gwC * rpw; hi = lo + rpw < M ? lo + rpw : M; }
    if (lo > hi) lo = hi;
}
__device__ __forceinline__ void hand_wait(const Frame& F, gu32* hand, int nl, int nseg, int wave, unsigned want) {
    if (!hand) return;
    if (wave == 0) {
        for (int seg = 0; seg < nseg; ++seg) { int lo, hi, lo7, hi7; const RowDeal d0 = row_deal(F, 0, nl), d7 = row_deal(F, NWAVES - 1, nl); wave_rows(d0, seg, lo, hi); wave_rows(d7, seg, lo7, hi7);
            if (hi7 > lo7) hi = hi7; if (lo >= hi) continue;
            for (int p = lo >> 8; p <= ((hi - 1) >> 8); ++p) { unsigned spins = 0;
                while ((unsigned)__builtin_amdgcn_readfirstlane(__hip_atomic_load(hand + 64 * p, RLX_AGENT)) < want) { __builtin_amdgcn_s_sleep(8);
                    if (++spins > (1u << 21)) { __hip_atomic_store(F.ctl + 2, 1u, RLX_AGENT); break; } } } }
        __builtin_amdgcn_fence(__ATOMIC_ACQUIRE, "agent"); asm volatile("s_waitcnt vmcnt(0)" ::: "memory");
    }
    __syncthreads();
}
__device__ __forceinline__ void ph_norm1(Frame& F, const float* const* in, int l, const float* xl, const float* xc) {
    int tid = F.tid; asm volatile("" : "+v"(tid)); const int lane = tid & 63; const int wave = __builtin_amdgcn_readfirstlane(tid >> 6);
    const int gw = F.vcu * NWAVES + wave, NGW = F.G * NWAVES;
    const float* mod = (const float*)(F.ws + WS_MOD) + (size_t)l * 5 * 6144; const float* ng = in[6] + (size_t)l * 4 * D;
    const RowDeal rd = row_deal(F, wave, 0); (void)gw; (void)NGW;
    for (int seg = 0; seg < 2; ++seg) { int lo, hi; wave_rows(rd, seg, lo, hi); const int n = hi - lo; int cur = -1; f32x4 b1[4], b2[4]; f32x4 rx[3][4];
#pragma unroll
        for (int u = 0; u < 3; ++u) if (u < n) load_row_f32(xrow_ptr(xl, xc, lo + u), rx[u], lane);
        for (int i = 0; i < n; i += 3) {
#pragma unroll
            for (int u = 0; u < 3; ++u) { if (i + u < n) { const int m = lo + i + u; const int mr = mod_row(m);
                if (mr != cur) { cur = mr; const float* mp = mod + mr * 6144;
#pragma unroll
                    for (int j = 0; j < 4; ++j) { const int c = 256 * j + 4 * lane; b1[j] = *(const f32x4*)(ng + c) * (*(const f32x4*)(mp + 1024 + c) + 1.0f); b2[j] = *(const f32x4*)(mp + c); } }
                f32x4 x[4];
#pragma unroll
                for (int j = 0; j < 4; ++j) x[j] = rx[u][j];
                if (i + u + 3 < n) load_row_f32(xrow_ptr(xl, xc, m + 3), rx[u], lane);
                norm_mod_store(x, b1, b2, (bf16*)(F.ws + WS_XN) + (size_t)m * D, lane, true, F.ws + WS_AR + AR_XN8 + (size_t)m * D); } } }
    }
}
struct Tiles {
    int c0, c1, c2, c3, c4, c5, c6, c7, n0, n1, n2, n3, n4, n5, n6, n7;
    __device__ __forceinline__ void load(const gu32* fill) {
#define TL_(e) c##e = (int)__builtin_amdgcn_readfirstlane(__hip_atomic_load(fill + 64 * e, RLX_AGENT)); n##e = (c##e + 255) >> 8;
        TL_(0) TL_(1) TL_(2) TL_(3) TL_(4) TL_(5) TL_(6) TL_(7)
#undef TL_
    }
    __device__ __forceinline__ int f1() const { return n0; }
    __device__ __forceinline__ int f2() const { return n0 + n1; }
    __device__ __forceinline__ int f3() const { return n0 + n1 + n2; }
    __device__ __forceinline__ int f4() const { return n0 + n1 + n2 + n3; }
    __device__ __forceinline__ int f5() const { return n0 + n1 + n2 + n3 + n4; }
    __device__ __forceinline__ int f6() const { return n0 + n1 + n2 + n3 + n4 + n5; }
    __device__ __forceinline__ int f7() const { return n0 + n1 + n2 + n3 + n4 + n5 + n6; }
    __device__ __forceinline__ int nt() const { return n0 + n1 + n2 + n3 + n4 + n5 + n6 + n7; }
    __device__ __forceinline__ int first(int e) const { return (e > 0 ? n0 : 0) + (e > 1 ? n1 : 0) + (e > 2 ? n2 : 0) + (e > 3 ? n3 : 0) + (e > 4 ? n4 : 0) + (e > 5 ? n5 : 0) + (e > 6 ? n6 : 0); }
    __device__ __forceinline__ int cnt(int e) const { return (e == 0 ? c0 : 0) + (e == 1 ? c1 : 0) + (e == 2 ? c2 : 0) + (e == 3 ? c3 : 0) + (e == 4 ? c4 : 0) + (e == 5 ? c5 : 0) + (e == 6 ? c6 : 0) + (e == 7 ? c7 : 0); }
    __device__ __forceinline__ int expert_of(int pm) const { return (pm >= f1()) + (pm >= f2()) + (pm >= f3()) + (pm >= f4()) + (pm >= f5()) + (pm >= f6()) + (pm >= f7()); }
};

struct MidVec { f32x4 a1[4], a2[4], sf[4]; };
__device__ __forceinline__ void mid_row(Frame& F, const MidVec& V, f32x4 (&y)[4], f32x4 (&x)[4], int m, bool valid, bool moe, bool f8, float* xo, const float* br, LAS float* wr, LAS float* recw, int& nrec, int lane) {
    const float rstd = row_rstd(y);
#pragma unroll
    for (int j = 0; j < 4; ++j) { x[j] = x[j] + V.a1[j] * (y[j] * rstd);
        if (valid) { if (XBF16) { v2u w; w.x = pk2(x[j].x, x[j].y); w.y = pk2(x[j].z, x[j].w); *(v2u*)((bf16*)(F.ws + WS_XB) + (size_t)m * D + 256 * j + 4 * lane) = w; } else *(f32x4*)(xo + 256 * j + 4 * lane) = x[j]; } }
    const float rstd2 = row_rstd(x);
    unsigned char* orow8 = F.ws + WS_AR + AR_XF + (size_t)m * D; bf16* orow = (bf16*)(F.ws + WS_AR + AR_XF) + (size_t)m * D;
    float lg[8];
#pragma unroll
    for (int e = 0; e < 8; ++e) lg[e] = 0.f;
#pragma unroll
    for (int j = 0; j < 4; ++j) { const int c = 256 * j + 4 * lane; const f32x4 h = (x[j] * rstd2) * V.a2[j] + V.sf[j];
        if (valid) { if (f8) { *(unsigned*)(orow8 + c) = pg8::pack_fp8x4(h.x * ASC, h.y * ASC, h.z * ASC, h.w * ASC); } else { v2u w; w.x = pk2(h.x, h.y); w.y = pk2(h.z, h.w); *(v2u*)(orow + c) = w; } }
        if (moe) {
#pragma unroll
            for (int e = 0; e < 8; ++e) { const f32x4 wv = *(const LAS f32x4*)(wr + e * 1024 + c); lg[e] += (h.x * wv.x + h.y * wv.y) + (h.z * wv.z + h.w * wv.w); } } }
    if (moe) {
#pragma unroll
        for (int e = 0; e < 8; ++e) lg[e] = wave_sum(lg[e]) + br[e];
        float b0 = lg[0]; int i0 = 0;
#pragma unroll
        for (int e = 1; e < 8; ++e) if (lg[e] > b0) { b0 = lg[e]; i0 = e; }
        float b1 = -3.0e38f; int i1 = 0;
#pragma unroll
        for (int e = 0; e < 8; ++e) if (e != i0 && lg[e] > b1) { b1 = lg[e]; i1 = e; }
        const float w0 = 1.0f / (1.0f + fast_exp(b1 - b0));
        if (valid) { if (lane == 0) { LAS float* r = recw + nrec * 4; r[0] = __uint_as_float((unsigned)(i0 | (i1 << 4))); r[1] = w0; r[2] = 1.0f - w0; r[3] = __uint_as_float((unsigned)m); } ++nrec; }
    }
}
__device__ __forceinline__ void ph_mid(Frame& F, const float* const* in, int l, const float* xil, const float* xic, float* xol, float* xoc, gu32* hand, int nl) {
    int tid = F.tid; asm volatile("" : "+v"(tid)); const int lane = tid & 63; const int wave = __builtin_amdgcn_readfirstlane(tid >> 6);
    const int gw = F.vcu * NWAVES + wave, NGW = F.G * NWAVES; const bool moe = (l & 1) != 0; const bool f8 = gu_fp8(l);
    const float* mod = (const float*)(F.ws + WS_MOD) + (size_t)l * 5 * 6144; const float* ng = in[6] + (size_t)l * 4 * D;
    const bf16* Y = (const bf16*)(F.ws + WS_AR + AR_Y);
    LAS float* wr = (LAS float*)F.lds;
    LAS float* rec = (LAS float*)(F.lds + 32768);
    LAS unsigned* lcnt = (LAS unsigned*)(F.lds + 32768 + 8192);
    if (moe) {
        const float* wrt = in[17] + (size_t)(l >> 1) * D * NEXP;
        for (int idx = tid; idx < D * NEXP; idx += 512) { const int c = idx >> 3, e = idx & 7; wr[e * 1024 + c] = wrt[idx]; }
        if (tid < 24) lcnt[tid] = 0u;
        __syncthreads();
    }
    const float* br = in[18] + (l >> 1) * NEXP;
    int nrec = 0; LAS float* recw = rec + wave * 64 * 4;
    const int nseg = (l == DEPTH - 1) ? 1 : 2;
    const RowDeal rd = row_deal(F, wave, nl); (void)gw; (void)NGW;
    hand_wait(F, hand, nl, nseg, wave, 32u);
    for (int seg = 0; seg < nseg; ++seg) { int lo, hi; wave_rows(rd, seg, lo, hi); const int n = hi - lo; int cur = -1; MidVec V;
        v2u ry[3][4]; f32x4 rx[3][4]; v2u rxb[3][4];
        const bool xin32 = !XBF16 || l == 0; const bf16* XB = (const bf16*)(F.ws + WS_XB);
#define MID_LOAD(u, m_) do { const bf16* yp_ = Y + (size_t)(m_) * D; const float* xp_ = xrow_ptr(xil, xic, (m_)); _Pragma("unroll") for (int j = 0; j < 4; ++j) { ry[u][j] = *(const v2u*)(yp_ + 256 * j + 4 * lane); if (xin32) rx[u][j] = *(const f32x4*)(xp_ + 256 * j + 4 * lane); else rxb[u][j] = *(const v2u*)(XB + (size_t)(m_) * D + 256 * j + 4 * lane); } } while (0)
#pragma unroll
        for (int u = 0; u < 3; ++u) if (u < n) MID_LOAD(u, lo + u);
        for (int i = 0; i < n; i += 3) {
#pragma unroll
            for (int u = 0; u < 3; ++u) { if (i + u < n) { const int m = lo + i + u; const int mr = mod_row(m);
                if (mr != cur) { cur = mr; const float* mp = mod + mr * 6144;
#pragma unroll
                    for (int j = 0; j < 4; ++j) { const int c = 256 * j + 4 * lane; V.a1[j] = *(const f32x4*)(mp + 2048 + c) * *(const f32x4*)(ng + D + c);
                        V.a2[j] = *(const f32x4*)(ng + 2 * D + c) * (*(const f32x4*)(mp + 4096 + c) + 1.0f); V.sf[j] = *(const f32x4*)(mp + 3072 + c); } }
                f32x4 y[4], x[4];
#pragma unroll
                for (int j = 0; j < 4; ++j) { const v2u w = ry[u][j]; y[j] = (f32x4){bflo(w.x), bfhi(w.x), bflo(w.y), bfhi(w.y)}; if (xin32) x[j] = rx[u][j]; else { const v2u b = rxb[u][j]; x[j] = (f32x4){bflo(b.x), bfhi(b.x), bflo(b.y), bfhi(b.y)}; } }
                if (i + u + 3 < n) MID_LOAD(u, m + 3);
                mid_row(F, V, y, x, m, true, moe, f8, xrow_ptr(xol, xoc, m), br, wr, recw, nrec, lane); } } }
#undef MID_LOAD
    }
    if (moe) {
        if (lane == 0) lcnt[16 + wave] = (unsigned)nrec;
        __syncthreads();
        gu32* fill = F.ctl + CW_FILL + (l >> 1) * 8 * 64;
        const int w = tid >> 6, ii = tid & 63; const bool valid = ii < (int)lcnt[16 + w];
        unsigned ee = 0u; float w0 = 0.f, w1 = 0.f; unsigned r0 = 0u, r1 = 0u; int m = 0;
        if (valid) { const LAS float* r = rec + (w * 64 + ii) * 4; ee = __float_as_uint(r[0]); w0 = r[1]; w1 = r[2]; m = (int)__float_as_uint(r[3]);
            r0 = __hip_atomic_fetch_add(lcnt + (ee & 15u), 1u, __ATOMIC_RELAXED, __HIP_MEMORY_SCOPE_WORKGROUP); r1 = __hip_atomic_fetch_add(lcnt + (ee >> 4), 1u, __ATOMIC_RELAXED, __HIP_MEMORY_SCOPE_WORKGROUP); }
        __syncthreads();
        if (tid < 8) lcnt[8 + tid] = __hip_atomic_fetch_add(fill + 64 * tid, lcnt[tid], RLX_AGENT);
        __syncthreads();
        if (valid) { const unsigned e0 = ee & 15u, e1 = ee >> 4; const unsigned s0 = lcnt[8 + e0] + r0, s1 = lcnt[8 + e1] + r1;
            int* list = (int*)(F.ws + WS_LIST); list[(size_t)e0 * M + s0] = m; list[(size_t)e1 * M + s1] = m;
            unsigned* ts = (unsigned*)(F.ws + WS_TOKSLOT); ts[2 * m] = e0 | (s0 << 3); ts[2 * m + 1] = e1 | (s1 << 3);
            float* tw = (float*)(F.ws + WS_TOKW); tw[2 * m] = w0; tw[2 * m + 1] = w1; }
        __syncthreads();
    }
}
__device__ __forceinline__ void ph_end(Frame& F, const float* const* in, int l, float* xl, float* xc, gu32* hand, int nl) {
    int tid = F.tid; asm volatile("" : "+v"(tid)); const int lane = tid & 63; const int wave = __builtin_amdgcn_readfirstlane(tid >> 6);
    const int gw = F.vcu * NWAVES + wave, NGW = F.G * NWAVES; const bool moe = (l & 1) != 0; const bool nxt = l + 1 < DEPTH;
    const float* mod = (const float*)(F.ws + WS_MOD) + (size_t)l * 5 * 6144; const float* ng = in[6] + (size_t)l * 4 * D;
    const bf16* Y = (const bf16*)(F.ws + WS_AR + AR_XG);
    Tiles T; T.load(F.ctl + CW_FILL + (l >> 1) * 8 * 64);
    const int nseg = (l == DEPTH - 1) ? 1 : 2;
    const RowDeal rd = row_deal(F, wave, nl); (void)gw; (void)NGW;
    hand_wait(F, hand, nl, nseg, wave, 32u);
    for (int seg = 0; seg < nseg; ++seg) { int lo, hi; wave_rows(rd, seg, lo, hi); const int n = hi - lo; int cur = -1; f32x4 a3[4], b1[4], b2[4];
        int p0v = 0, p1v = 0; float w0v = 0.f, w1v = 0.f;
        if (moe && lane < n) { const unsigned* ts = (const unsigned*)(F.ws + WS_TOKSLOT); const float* tw = (const float*)(F.ws + WS_TOKW); const int m = lo + lane;
            const unsigned s0 = ts[2 * m], s1 = ts[2 * m + 1]; w0v = tw[2 * m]; w1v = tw[2 * m + 1];
            p0v = T.first((int)(s0 & 7u)) * 256 + (int)(s0 >> 3); p1v = T.first((int)(s1 & 7u)) * 256 + (int)(s1 >> 3); }
        v2u ry[3][4], rz[3][4]; f32x4 rx[3][4]; v2u rxb[3][4]; const bf16* XB = (const bf16*)(F.ws + WS_XB); const bool lastl = (l == DEPTH - 1);
#define END_LOAD(u, i_) do { const int m_ = lo + (i_); const float* xp_ = xrow_ptr(xl, xc, m_); \
            if (moe) { const int q0_ = __builtin_amdgcn_readlane(p0v, (i_)), q1_ = __builtin_amdgcn_readlane(p1v, (i_)); const bf16* ya_ = Y + (size_t)q0_ * D; const bf16* yb_ = Y + (size_t)q1_ * D; \
                _Pragma("unroll") for (int j = 0; j < 4; ++j) { ry[u][j] = *(const v2u*)(ya_ + 256 * j + 4 * lane); rz[u][j] = *(const v2u*)(yb_ + 256 * j + 4 * lane); } } \
            else { const bf16* ya_ = Y + (size_t)m_ * D; _Pragma("unroll") for (int j = 0; j < 4; ++j) ry[u][j] = *(const v2u*)(ya_ + 256 * j + 4 * lane); } \
            _Pragma("unroll") for (int j = 0; j < 4; ++j) { if (XBF16) rxb[u][j] = *(const v2u*)(XB + (size_t)m_ * D + 256 * j + 4 * lane); else rx[u][j] = *(const f32x4*)(xp_ + 256 * j + 4 * lane); } } while (0)
#pragma unroll
        for (int u = 0; u < 3; ++u) if (u < n) END_LOAD(u, u);
        for (int i = 0; i < n; i += 3) {
#pragma unroll
            for (int u = 0; u < 3; ++u) { if (i + u < n) { const int m = lo + i + u; const int mr = mod_row(m);
                if (mr != cur) { cur = mr; const float* mp = mod + mr * 6144; const float* mp2 = mp + 5 * 6144;
#pragma unroll
                    for (int j = 0; j < 4; ++j) { const int c = 256 * j + 4 * lane; a3[j] = *(const f32x4*)(mp + 5120 + c) * *(const f32x4*)(ng + 3 * D + c);
                        if (nxt) { b1[j] = *(const f32x4*)(ng + 4 * D + c) * (*(const f32x4*)(mp2 + 1024 + c) + 1.0f); b2[j] = *(const f32x4*)(mp2 + c); } else { b1[j] = a3[j]; b2[j] = a3[j]; } } }
                f32x4 y[4], x[4];
                if (moe) { const float w0 = __uint_as_float(__builtin_amdgcn_readlane(__float_as_uint(w0v), i + u)), w1 = __uint_as_float(__builtin_amdgcn_readlane(__float_as_uint(w1v), i + u));
#pragma unroll
                    for (int j = 0; j < 4; ++j) { const v2u a = ry[u][j], b = rz[u][j];
                        y[j] = (f32x4){bflo(a.x), bfhi(a.x), bflo(a.y), bfhi(a.y)} * w0 + (f32x4){bflo(b.x), bfhi(b.x), bflo(b.y), bfhi(b.y)} * w1; } }
                else {
#pragma unroll
                    for (int j = 0; j < 4; ++j) { const v2u a = ry[u][j]; y[j] = (f32x4){bflo(a.x), bfhi(a.x), bflo(a.y), bfhi(a.y)}; } }
#pragma unroll
                for (int j = 0; j < 4; ++j) { if (XBF16) { const v2u b = rxb[u][j]; x[j] = (f32x4){bflo(b.x), bfhi(b.x), bflo(b.y), bfhi(b.y)}; } else x[j] = rx[u][j]; }
                if (i + u + 3 < n) END_LOAD(u, i + u + 3);
                float* xp = xrow_ptr(xl, xc, m);
                const float rstd = row_rstd(y);
#pragma unroll
                for (int j = 0; j < 4; ++j) { x[j] = x[j] + a3[j] * (y[j] * rstd);
                    if (XBF16 && !lastl) { v2u w; w.x = pk2(x[j].x, x[j].y); w.y = pk2(x[j].z, x[j].w); *(v2u*)((bf16*)(F.ws + WS_XB) + (size_t)m * D + 256 * j + 4 * lane) = w; } else *(f32x4*)(xp + 256 * j + 4 * lane) = x[j]; }
                if (nxt) norm_mod_store(x, b1, b2, (bf16*)(F.ws + WS_XN) + (size_t)m * D, lane, true, F.ws + WS_AR + AR_XN8 + (size_t)m * D); } } }
#undef END_LOAD
    }
}
template <int H> __device__ __forceinline__ void pooled_item(const bf16* P, bf16* PO, int m, int c8, int t, int L, int base) {
    v4u w[2 * H]; float s[8];
#pragma unroll
    for (int k = 0; k < 2 * H; ++k) { int r = t - H + k; r = r < 0 ? 0 : (r >= L ? L - 1 : r); w[k] = *(const v4u*)(P + (size_t)(base + r) * 512 + c8); }
#pragma unroll
    for (int j = 0; j < 8; ++j) s[j] = 0.f;
#pragma unroll
    for (int k = 0; k < 2 * H; ++k) { const int r = t - H + k; const float ok = (r >= 0 && r < L) ? 1.0f : 0.0f; const v4u x = w[k];
        s[0] += ok * bflo(x.x); s[1] += ok * bfhi(x.x); s[2] += ok * bflo(x.y); s[3] += ok * bfhi(x.y); s[4] += ok * bflo(x.z); s[5] += ok * bfhi(x.z); s[6] += ok * bflo(x.w); s[7] += ok * bfhi(x.w); }
    const int lo = t - H < 0 ? 0 : t - H, hi = t + H > L ? L : t + H; const float inv = 1.0f / (float)(hi - lo); const v4u c = w[H];
    v4u o; o.x = pk2(s[0] * inv - bflo(c.x), s[1] * inv - bfhi(c.x)); o.y = pk2(s[2] * inv - bflo(c.y), s[3] * inv - bfhi(c.y));
    o.z = pk2(s[4] * inv - bflo(c.z), s[5] * inv - bfhi(c.z)); o.w = pk2(s[6] * inv - bflo(c.w), s[7] * inv - bfhi(c.w));
    *(v4u*)(PO + (size_t)m * 512 + c8) = o;
}
__device__ __forceinline__ void ph_pooled(Frame& F, int rows, int nlight) {
    int tid = F.tid; asm volatile("" : "+v"(tid)); const int lane = tid & 63; const int wave = __builtin_amdgcn_readfirstlane(tid >> 6);
    const bf16* P = (const bf16*)(F.ws + WS_AR + AR_P); bf16* PO = (bf16*)(F.ws + WS_AR + AR_POOLED);
    const int nitems = rows;
    const bool light = F.vcu < nlight; const int NV = nlight * NWAVES + (F.G - nlight) * NWAVES * 2;
    const int s0 = light ? F.vcu * NWAVES + wave : nlight * NWAVES + ((F.vcu - nlight) * NWAVES + wave) * 2;
    int k = 0;
    for (int j0 = s0; j0 < nitems; j0 += NV, ++k) {
        for (int d = 0; d < (light ? 1 : 2); ++d) { const int j = j0 + d; if (j >= nitems) break;
            const int gi = ((j & 3) + k) & 3, q = j >> 2;
            const int m = 4 * q + (lane >> 4), c8 = gi * 128 + (lane & 15) * 8;
            int t, L, base; if (m < M_LAT) { t = m & 8191; L = SEQ; base = m - t; } else { t = (m - M_LAT) & 255; L = CTXL; base = m - t; }
            if (gi == 0) pooled_item<1>(P, PO, m, c8, t, L, base); else if (gi == 1) pooled_item<2>(P, PO, m, c8, t, L, base);
            else if (gi == 2) pooled_item<4>(P, PO, m, c8, t, L, base); else pooled_item<8>(P, PO, m, c8, t, L, base); } }
}

constexpr float ATT_THR = 8.0f;
constexpr int AT_KP = 144, AT_VP = 136;
constexpr int AT_KB = 64 * AT_KP, AT_VB = 64 * AT_VP;
__device__ __forceinline__ void attn_unit(Frame& F, int b, int kvh, int qb, bool lat, const float* sinks) {
    int tid = F.tid; asm volatile("" : "+v"(tid)); const int lane = tid & 63; const int wave = __builtin_amdgcn_readfirstlane(tid >> 6); (void)lane; (void)wave;

    const int wid = wave, r32 = lane & 31, hi = lane >> 5;
    const bf16* Q = (const bf16*)(F.ws + WS_AR + AR_Q); const bf16* Kg = (const bf16*)(F.ws + WS_AR + AR_K); const bf16* VT = (const bf16*)(F.ws + WS_AR + AR_VT); bf16* O = (bf16*)(F.ws + WS_AR + AR_ATT);
    const int hq = kvh * 4 + (wid >> 1);
    const int qrow = (lat ? b * SEQ + qb * 64 : M_LAT + b * CTXL + qb * 64) + (wid & 1) * 32 + r32;
    bf16x8 qf[4];
#pragma unroll
    for (int d0 = 0; d0 < 4; ++d0) qf[d0] = *(const bf16x8*)(Q + (size_t)qrow * 512 + hq * 64 + d0 * 16 + hi * 8);
    int t_lo = 0, n_loc = 0;
    if (lat) { t_lo = qb - 2 < 0 ? 0 : qb - 2; const int t_hi = qb + 2 > 127 ? 127 : qb + 2; n_loc = t_hi - t_lo + 1; }
    const int nt = n_loc + 4;
    const int srow = tid >> 3, sch = tid & 7;
    const bf16* vbase = VT + ((size_t)((b * 2 + kvh) * 64 + srow)) * VTP + sch * 8;
    LAS unsigned char* kl = F.lds + srow * AT_KP + sch * 16; LAS unsigned char* vl = F.lds + 2 * AT_KB + srow * AT_VP + sch * 16;
    v4u kreg, vreg, kreg2, vreg2;
#define AT_LOAD(KR, VR, t) do { const int _t = (t); int krow, kk0; if (_t < n_loc) { kk0 = (t_lo + _t) * 64; krow = b * SEQ + kk0; } else { kk0 = SEQ + (_t - n_loc) * 64; krow = M_LAT + b * CTXL + (_t - n_loc) * 64; } \
        KR = *(const v4u*)(Kg + (size_t)(krow + srow) * 128 + kvh * 64 + sch * 8); VR = *(const v4u*)(vbase + kk0); } while (0)
    AT_LOAD(kreg, vreg, 0); if (1 < nt) AT_LOAD(kreg2, vreg2, 1);
    const float sk = sinks[hq] * 1.4426950408889634f;
    float mst = sk, lrun = hi == 0 ? 1.0f : 0.0f;
    f32x16 negm;
#pragma unroll
    for (int r = 0; r < 16; ++r) negm[r] = -mst;
    f32x16 o0 = {}, o1 = {};
    const int qpos = qb * 64 + (wid & 1) * 32 + r32;
#define AT_TILE(KR, VR, TT) do { \
        const int buf = (TT) & 1; \
        *(LAS v4u*)(kl + buf * AT_KB) = KR; { LAS v2u* vp = (LAS v2u*)(vl + buf * AT_VB); vp[0] = (v2u){VR.x, VR.y}; vp[1] = (v2u){VR.z, VR.w}; } \
        __syncthreads(); \
        if ((TT) + 2 < nt) AT_LOAD(KR, VR, (TT) + 2); \
        const LAS unsigned char* kb = F.lds + buf * AT_KB + r32 * AT_KP + hi * 16; const LAS unsigned char* vb = F.lds + 2 * AT_KB + buf * AT_VB + r32 * AT_VP + hi * 8; \
        f32x16 p0 = negm, p1 = negm; \
_Pragma("unroll") \
        for (int d0 = 0; d0 < 4; ++d0) { const bf16x8 k0 = *(const LAS bf16x8*)(kb + d0 * 32), k1 = *(const LAS bf16x8*)(kb + 32 * AT_KP + d0 * 32); \
            p0 = __builtin_amdgcn_mfma_f32_32x32x16_bf16(k0, qf[d0], p0, 0, 0, 0); p1 = __builtin_amdgcn_mfma_f32_32x32x16_bf16(k1, qf[d0], p1, 0, 0, 0); } \
        if ((TT) < n_loc) { const int tk = t_lo + (TT); if (tk == qb - 2 || tk == qb + 2) { const int kbase = tk * 64 + 4 * hi; \
_Pragma("unroll") \
                for (int r = 0; r < 16; ++r) { const int kp = kbase + (r & 3) + 8 * (r >> 2); int dd = qpos - kp; dd = dd < 0 ? -dd : dd; if (dd > 128) p0[r] = -INFINITY; int d2 = qpos - kp - 32; d2 = d2 < 0 ? -d2 : d2; if (d2 > 128) p1[r] = -INFINITY; } } } \
        float mxa = fmaxf(fmaxf(p0[0], p0[1]), p1[0]), mxb = fmaxf(fmaxf(p0[2], p0[3]), p1[1]); mxa = fmaxf(fmaxf(mxa, p1[2]), p1[3]); \
_Pragma("unroll") \
        for (int r = 4; r < 16; r += 4) { mxa = fmaxf(fmaxf(mxa, p0[r]), p0[r + 1]); mxb = fmaxf(fmaxf(mxb, p0[r + 2]), p0[r + 3]); mxa = fmaxf(fmaxf(mxa, p1[r]), p1[r + 1]); mxb = fmaxf(fmaxf(mxb, p1[r + 2]), p1[r + 3]); } \
        float rm = fmaxf(mxa, mxb); \
        { auto rr = __builtin_amdgcn_permlane32_swap(__float_as_uint(rm), __float_as_uint(rm), false, false); rm = fmaxf(__uint_as_float(rr[0]), __uint_as_float(rr[1])); } \
        if (__builtin_expect(__any(rm > ATT_THR), 0)) {            \
            const float dl = fmaxf(rm, 0.f); mst += dl; \
_Pragma("unroll") \
            for (int r = 0; r < 16; ++r) { p0[r] -= dl; p1[r] -= dl; negm[r] = -mst; } \
            const float f = __builtin_amdgcn_exp2f(-dl); lrun *= f; \
_Pragma("unroll") \
            for (int r = 0; r < 16; ++r) { o0[r] *= f; o1[r] *= f; } \
        } \
        float lsa = 0.f, lsb = 0.f; \
_Pragma("unroll") \
        for (int r = 0; r < 16; ++r) { p0[r] = __builtin_amdgcn_exp2f(p0[r]); p1[r] = __builtin_amdgcn_exp2f(p1[r]); lsa += p0[r]; lsb += p1[r]; } \
        lrun += lsa + lsb; \
        bf16x8 pb[4]; \
_Pragma("unroll") \
        for (int s = 0; s < 2; ++s) { v4u w; w.x = pk2(p0[8 * s], p0[8 * s + 1]); w.y = pk2(p0[8 * s + 2], p0[8 * s + 3]); w.z = pk2(p0[8 * s + 4], p0[8 * s + 5]); w.w = pk2(p0[8 * s + 6], p0[8 * s + 7]); pb[s] = __builtin_bit_cast(bf16x8, w); \
            v4u x; x.x = pk2(p1[8 * s], p1[8 * s + 1]); x.y = pk2(p1[8 * s + 2], p1[8 * s + 3]); x.z = pk2(p1[8 * s + 4], p1[8 * s + 5]); x.w = pk2(p1[8 * s + 6], p1[8 * s + 7]); pb[2 + s] = __builtin_bit_cast(bf16x8, x); } \
_Pragma("unroll") \
        for (int ks = 0; ks < 4; ++ks) {                  \
            const int ko = ((ks >> 1) * 32 + (ks & 1) * 16) * 2; \
            const v2u a0 = *(const LAS v2u*)(vb + ko), a1 = *(const LAS v2u*)(vb + ko + 16), c0 = *(const LAS v2u*)(vb + 32 * AT_VP + ko), c1 = *(const LAS v2u*)(vb + 32 * AT_VP + ko + 16); \
            const v4u va = (v4u){a0.x, a0.y, a1.x, a1.y}, vc = (v4u){c0.x, c0.y, c1.x, c1.y}; \
            o0 = __builtin_amdgcn_mfma_f32_32x32x16_bf16(__builtin_bit_cast(bf16x8, va), pb[ks], o0, 0, 0, 0); \
            o1 = __builtin_amdgcn_mfma_f32_32x32x16_bf16(__builtin_bit_cast(bf16x8, vc), pb[ks], o1, 0, 0, 0); } \
    } while (0)
    for (int t = 0; t < nt; t += 2) { AT_TILE(kreg, vreg, t); if (t + 1 < nt) AT_TILE(kreg2, vreg2, t + 1); }
#undef AT_TILE
#undef AT_LOAD
    { auto rr = __builtin_amdgcn_permlane32_swap(__float_as_uint(lrun), __float_as_uint(lrun), false, false); lrun = __uint_as_float(rr[0]) + __uint_as_float(rr[1]); }
    const float inv = 1.0f / lrun;
    bf16* orow = O + (size_t)qrow * 512 + hq * 64 + 4 * hi;
#pragma unroll
    for (int a = 0; a < 4; ++a) { v2u w; w.x = pk2(o0[4 * a] * inv, o0[4 * a + 1] * inv); w.y = pk2(o0[4 * a + 2] * inv, o0[4 * a + 3] * inv); *(v2u*)(orow + 8 * a) = w;
        v2u x; x.x = pk2(o1[4 * a] * inv, o1[4 * a + 1] * inv); x.y = pk2(o1[4 * a + 2] * inv, o1[4 * a + 3] * inv); *(v2u*)(orow + 32 + 8 * a) = x; }
    __syncthreads();
}
__device__ __forceinline__ void ph_attn(Frame& F, const float* sinks, int nunits) {
    for (int u = F.vcu; u < nunits; u += F.G) {
        if (u < 1024) { const int bh = u >> 7, qb = u & 127; attn_unit(F, bh >> 1, bh & 1, qb, true, sinks); }
        else { const int v = u - 1024; const int bh = v >> 2, qb = v & 3; attn_unit(F, bh >> 1, bh & 1, qb, false, sinks); }
    }
}


#ifndef MK_HANDOFF
#define MK_HANDOFF 0
#endif
#ifndef MK_ONE_LAUNCH
#define MK_ONE_LAUNCH 1
#endif
struct Args { const float* in[22]; float* out; unsigned char* ws; int ph_lo, ph_hi; };
__global__ void __launch_bounds__(NWAVES * 64, 2) fwd_kernel(Args args) {
    extern __shared__ __attribute__((aligned(16))) unsigned char lds[];
    Frame F;
    F.lds = (LAS unsigned char*)lds; F.MISC = (volatile LAS unsigned*)(F.lds + MISC_OFF);
    F.tid = threadIdx.x; F.lane = F.tid & 63; F.wave = __builtin_amdgcn_readfirstlane(F.tid >> 6);
    F.G = gridDim.x; { const int bx = blockIdx.x; F.vcu = (F.G % 8 == 0) ? (bx % 8) * (F.G / 8) + bx / 8 : bx; }
    F.ws = args.ws; F.ctl = (gu32*)(args.ws + WS_CTL);
    for (int u = F.tid; u < (LDS_BYTES - LDSCTL_OFF) / 4; u += NWAVES * 64) ((LAS unsigned*)(F.lds + LDSCTL_OFF))[u] = 0u;
    __syncthreads();
    const int lo = args.ph_lo, hi = args.ph_hi;
    XcdBarrier bar; bar.bar = (unsigned*)(F.ctl + CW_BAR); bar.x = 0; bar.st = nullptr;
    if (hi - lo > 1) bar = xcd_barrier_post((unsigned*)(F.ctl + CW_BAR), F.MISC + 8);
#define RUN(p) (lo <= (p) && (p) < hi)
#define PHASE_END(p) do { if ((p) + 1 < hi) xcd_barrier(bar); } while (0)
    const float* const* in = args.in;
    unsigned char* ws = args.ws;
    float* const xl = args.out; float* const xc = (float*)(ws + WS_CTXS);
    const int bx = (int)blockIdx.x;

    if (RUN(0)) { p0_prologue(F, in); PHASE_END(0); }

    for (int l = 0; l < DEPTH; ++l) {
        const int pb = 1 + 11 * l;
        if (hi <= pb) break;
        if (lo >= pb + 11) continue;
        const bool moe = (l & 1) != 0;
        const bool lastl = (l == DEPTH - 1); const int nMt = lastl ? M_LAT / 256 : M / 256;
        pg8::bf16_t* const XN = (pg8::bf16_t*)(ws + WS_XN);
        unsigned char* const ar = ws + WS_AR;
        if (RUN(pb + 0) && l == 0) { ph_norm1(F, in, 0, in[0], in[2]); PHASE_END(pb + 0); }
        if (RUN(pb + 1)) {
            unsigned char* const slot = ws + WS_WIN + (size_t)l * INW * D * 2;
            if (PF8) {
                { pg8::Gemm g8{(const pg8::bf16_t*)(ar + AR_XN8), (const pg8::bf16_t*)slot, M, NQKVP, D / 2}; pg8::GroupOrder S8; S8.init(M / 256, NQKVP, F.G, bx);
                  pg8::EpiIn E8{(pg8::bf16_t*)(ar + AR_Q), (pg8::bf16_t*)(ar + AR_K), (pg8::bf16_t*)(ar + AR_VT), (pg8::bf16_t*)(ar + AR_P), (pg8::bf16_t*)(ar + AR_G), (const float*)(ws + WS_ROPE), C2, 1.0f / (WSC * ASC), 5};
                  pg8::gemm_phase<pg8::EpiIn, pg8::GroupOrder, true, true, true>(F.lds, g8, S8, E8); }
                { pg8::Gemm g8{(const pg8::bf16_t*)(ar + AR_XN8), (const pg8::bf16_t*)(slot + (size_t)NQKVP * D), M, 2048, D / 2}; pg8::GroupOrder S8; S8.init(M / 256, 2048, F.G, bx);
                  pg8::EpiGate8 E8{(pg8::bf16_t*)(ar + AR_G), 1.0f / (WSC * ASC)};
                  pg8::gemm_phase<pg8::EpiGate8, pg8::GroupOrder, true, true, true>(F.lds, g8, S8, E8); }
            } else if (QKV8 && QKV1) {
                { pg8::Gemm g8{(const pg8::bf16_t*)(ar + AR_XN8), (const pg8::bf16_t*)slot, M, 2816, D / 2}; pg8::GroupOrder S8; S8.init(M / 256, 2816, F.G, bx);
                  pg8::EpiIn E8{(pg8::bf16_t*)(ar + AR_Q), (pg8::bf16_t*)(ar + AR_K), (pg8::bf16_t*)(ar + AR_VT), (pg8::bf16_t*)(ar + AR_P), (pg8::bf16_t*)(ar + AR_G), (const float*)(ws + WS_ROPE), C2, 1.0f / (WSC * ASC), 3};
                  pg8::gemm_phase<pg8::EpiIn, pg8::GroupOrder, true, true, true>(F.lds, g8, S8, E8); }
                { pg8::Gemm g{XN, (const pg8::bf16_t*)(slot + 3 * MiB), M, 512, D}; pg8::GroupOrder S; S.init(M / 256, 512, F.G, bx);
                  pg8::EpiCol8<0> E{(pg8::bf16_t*)(ar + AR_P), 512, nullptr, 0, nullptr, nullptr, 1.0f};
                  pg8::gemm_phase<pg8::EpiCol8<0>, pg8::GroupOrder, true, true>(F.lds, g, S, E); }
            } else if (QKV8) {
                const int G_ = F.G, o1 = (((M / 256) * 3) % G_ + 7) & ~7, o2 = ((o1 + nMt * 8) % G_ + 7) & ~7; const int c1 = (bx + G_ - o1 % G_) % G_, c2 = (bx + G_ - o2 % G_) % G_;
                { pg8::Gemm g8{(const pg8::bf16_t*)(ar + AR_XN8), (const pg8::bf16_t*)slot, M, 768, D / 2}; pg8::GroupOrder S8; S8.init(M / 256, 768, F.G, bx);
                  pg8::EpiIn E8{(pg8::bf16_t*)(ar + AR_Q), (pg8::bf16_t*)(ar + AR_K), (pg8::bf16_t*)(ar + AR_VT), (pg8::bf16_t*)(ar + AR_P), (pg8::bf16_t*)(ar + AR_G), (const float*)(ws + WS_ROPE), C2, 1.0f / (WSC * ASC), 3};
                  pg8::gemm_phase<pg8::EpiIn, pg8::GroupOrder, true, true, true>(F.lds, g8, S8, E8); }
                { pg8::Gemm g8{(const pg8::bf16_t*)(ar + AR_XN8), (const pg8::bf16_t*)(slot + (size_t)768 * D), M, 2048, D / 2}; pg8::GroupOrder S8; S8.init(nMt, 2048, F.G, c1);
                  pg8::EpiGate8 E8{(pg8::bf16_t*)(ar + AR_G), 1.0f / (WSC * ASC)};
                  pg8::gemm_phase<pg8::EpiGate8, pg8::GroupOrder, true, true, true>(F.lds, g8, S8, E8); }
                { pg8::Gemm g{XN, (const pg8::bf16_t*)(slot + 3 * MiB), M, 512, D}; pg8::GroupOrder S; S.init(nMt, 512, F.G, c2);
                  pg8::EpiCol8<0> E{(pg8::bf16_t*)(ar + AR_P), 512, nullptr, 0, nullptr, nullptr, 1.0f};
                  pg8::gemm_phase<pg8::EpiCol8<0>, pg8::GroupOrder, true, true>(F.lds, g, S, E); }
            } else {
            pg8::Gemm g{XN, (const pg8::bf16_t*)slot, M, GATE8 ? NQKVP : INW, D}; pg8::GroupOrder S; S.init(M / 256, GATE8 ? NQKVP : INW, F.G, bx);
            pg8::EpiIn E{(pg8::bf16_t*)(ar + AR_Q), (pg8::bf16_t*)(ar + AR_K), (pg8::bf16_t*)(ar + AR_VT), (pg8::bf16_t*)(ar + AR_P), (pg8::bf16_t*)(ar + AR_G), (const float*)(ws + WS_ROPE), C2, 1.0f, 5};
            pg8::gemm_phase<pg8::EpiIn, pg8::GroupOrder, true, true>(F.lds, g, S, E);
            if (GATE8) {
                pg8::Gemm g8{(const pg8::bf16_t*)(ar + AR_XN8), (const pg8::bf16_t*)(slot + (size_t)NQKVP * D * 2), M, 2048, D / 2}; pg8::GroupOrder S8; S8.init(M / 256, 2048, F.G, bx);
                pg8::EpiGate8 E8{(pg8::bf16_t*)(ar + AR_G), 1.0f / (WSC * ASC)};
                pg8::gemm_phase<pg8::EpiGate8, pg8::GroupOrder, true, true, true>(F.lds, g8, S8, E8); }
            }
            PHASE_END(pb + 1);
        }
        if (RUN(pb + 2)) {
            const bool cv = (l == 2), cvfirst = (F.vcu & 1) != 0;
            for (int step = 0; step < 2; ++step) { if (cv && ((step == 0) == cvfirst)) conv_experts(F, in, 1); if (step == (cv && cvfirst ? 1 : 0)) { ph_attn(F, in[8] + l * 8, lastl ? 1024 : 1056); ph_pooled(F, lastl ? M_LAT : M, (F.G % 8 == 0 && F.G >= 64) ? (lastl ? 1024 : 1056) % F.G : 0); } if (cv) __syncthreads(); }
            PHASE_END(pb + 2); }
        if (RUN(pb + 3)) {
            { pg8::Gemm g{(const pg8::bf16_t*)(ar + AR_ATT), (const pg8::bf16_t*)(ws + WS_WAO) + (size_t)l * D * 512, M, D, 512}; pg8::GroupOrder S; S.init(nMt, D, F.G, bx);
              pg8::EpiCol8<1, false> E{(pg8::bf16_t*)(ar + AR_T1), D, (const pg8::bf16_t*)(ar + AR_G), 0, nullptr, nullptr, 1.0f};
              pg8::gemm_phase<pg8::EpiCol8<1, false>, pg8::GroupOrder, true, true>(F.lds, g, S, E); }
            { pg8::Gemm g{(const pg8::bf16_t*)(ar + AR_POOLED), (const pg8::bf16_t*)(ws + WS_WPO) + (size_t)l * D * 512, M, D, 512}; pg8::GroupOrder S; S.init(nMt, D, F.G, bx);
              pg8::EpiCol8<2> E{(pg8::bf16_t*)(ar + AR_MERGED), D, (const pg8::bf16_t*)(ar + AR_G), 1024, (const pg8::bf16_t*)(ar + AR_T1), nullptr, 1.0f};
              pg8::gemm_phase<pg8::EpiCol8<2>, pg8::GroupOrder, true, true>(F.lds, g, S, E); }
            PHASE_END(pb + 3);
        }
        const int nl_mix = nMt * 4 > 2 * F.G ? nMt * 4 - 2 * F.G : 0;
        gu32* const hand_mix = F.ctl + CW_HAND + l * HAND_BANK;
        if (RUN(pb + 5)) {
            pg8::Gemm g{(const pg8::bf16_t*)(ar + AR_MERGED), (const pg8::bf16_t*)(ws + WS_WOUT) + (size_t)l * D * D, M, D, D}; pg8::GroupOrder S; S.init(nMt, D, F.G, bx);
            const bool ho = MK_HANDOFF && RUN(pb + 6); if (ho) S.hand = (unsigned*)hand_mix;
            pg8::EpiCol8<0, (MK_HANDOFF != 0)> E{(pg8::bf16_t*)(ar + AR_Y), D, nullptr, 0, nullptr, nullptr, 1.0f};
            pg8::gemm_phase<pg8::EpiCol8<0, (MK_HANDOFF != 0)>, pg8::GroupOrder, true, true>(F.lds, g, S, E);
            if (!ho) PHASE_END(pb + 5);
        }
        if (RUN(pb + 6)) {
            { const bool hi_ = MK_HANDOFF && RUN(pb + 5); gu32* hd = hi_ ? hand_mix : nullptr; const int nl = hi_ ? nl_mix : 0;
              if (l == 0) ph_mid(F, in, l, in[0], in[2], xl, xc, hd, nl); else ph_mid(F, in, l, xl, xc, xl, xc, hd, nl); }
            PHASE_END(pb + 6);
        }
        if (RUN(pb + 8)) {
            const bool f8 = gu_fp8(l), o8 = dn_fp8(l); const int esz = f8 ? 1 : 2;
            pg8::GroupOrder S; pg8::Gemm g;
            const int ff = moe ? DFFE : DFF;
            LAS unsigned short* rl = (LAS unsigned short*)(F.lds + RL_OFF);
            if (moe) { Tiles T; T.load(F.ctl + CW_FILL + (l >> 1) * 8 * 64);
                g = pg8::Gemm{(const pg8::bf16_t*)(ar + AR_XF), (const pg8::bf16_t*)(ws + WS_WEGU), T.nt() * 256, 2 * DFFE, D * esz / 2}; S.init(T.nt(), 2 * DFFE, F.G, bx);
                S.t1 = T.f1(); S.t2 = T.f2(); S.t3 = T.f3(); S.t4 = T.f4(); S.t5 = T.f5(); S.t6 = T.f6(); S.t7 = T.f7(); S.estride = (size_t)2 * DFFE * D * esz;
                const int* list = (const int*)(ws + WS_LIST);
                for (int i0 = 0; i0 < RL_UNITS; i0 += 10) { int tok[10];
#pragma unroll
                    for (int d = 0; d < 10; ++d) { pg8::Unit u; tok[d] = -1; if (S.next(i0 + d, u)) { const int e = T.expert_of(u.pm); const int local = (u.pm - T.first(e)) * 256 + (F.tid & 255);
                        tok[d] = (F.tid < 256 && local < T.cnt(e)) ? list[(size_t)e * M + local] : 0; } }
#pragma unroll
                    for (int d = 0; d < 10; ++d) if (tok[d] >= 0 && F.tid < 256) rl[(i0 + d) * 256 + F.tid] = (unsigned short)tok[d]; }
            } else {
                { pg8::GroupOrder S0; S0.init(M / 256, 2 * DFF, F.G, bx);
                  for (int i = 0; i < RL_UNITS; ++i) { pg8::Unit u; if (!S0.next(i, u)) break; if (F.tid < 256) rl[i * 256 + F.tid] = (unsigned short)(u.pm * 256 + F.tid); } }
                const unsigned char* wb = f8 ? ws + WS_W8GU + (size_t)(l >> 1) * 2 * DFF * D : ws + WS_WGU + (size_t)(l >> 1) * 2 * DFF * D * 2;
                g = pg8::Gemm{(const pg8::bf16_t*)(ar + AR_XF), (const pg8::bf16_t*)wb, M, 2 * DFF, D * esz / 2}; S.init(M / 256, 2 * DFF, F.G, bx);
            }
            S.rl = (const LAS unsigned short*)rl; __syncthreads();
            if (any_combo(true, true) && f8 && o8) { pg8::EpiSwiglu<true, true> E{(void*)(ar + AR_HID), ff, 1.0f / (WSC * ASC), HSC}; pg8::gemm_phase<pg8::EpiSwiglu<true, true>, pg8::GroupOrder, true, true, true, true>(F.lds, g, S, E); }
            if (any_combo(true, false) && f8 && !o8) { pg8::EpiSwiglu<true, false> E{(void*)(ar + AR_HID), ff, 1.0f / (WSC * ASC), 1.0f}; pg8::gemm_phase<pg8::EpiSwiglu<true, false>, pg8::GroupOrder, true, true, true, true>(F.lds, g, S, E); }
            if (any_combo(false, true) && !f8 && o8) { pg8::EpiSwiglu<false, true> E{(void*)(ar + AR_HID), ff, 1.0f, HSC}; pg8::gemm_phase<pg8::EpiSwiglu<false, true>, pg8::GroupOrder, true, true, false, true>(F.lds, g, S, E); }
            if (any_combo(false, false) && !f8 && !o8) { pg8::EpiSwiglu<false, false> E{(void*)(ar + AR_HID), ff, 1.0f, 1.0f}; pg8::gemm_phase<pg8::EpiSwiglu<false, false>, pg8::GroupOrder, true, true, false, true>(F.lds, g, S, E); }
            PHASE_END(pb + 8);
        }
        if (RUN(pb + 9)) {
            const bool f8 = dn_fp8(l); const int esz = f8 ? 1 : 2;
            pg8::GroupOrder S; pg8::Gemm g; pg8::EpiCol8<0, (MK_HANDOFF != 0)> E{(pg8::bf16_t*)(ar + AR_XG), D, nullptr, 0, nullptr, nullptr, f8 ? 1.0f / (WSC * HSC) : 1.0f};
            const bool ho = MK_HANDOFF && !moe && RUN(pb + 10);
            if (moe) { Tiles T; T.load(F.ctl + CW_FILL + (l >> 1) * 8 * 64);
                g = pg8::Gemm{(const pg8::bf16_t*)(ar + AR_HID), (const pg8::bf16_t*)(ws + WS_WEDN), T.nt() * 256, D, DFFE * esz / 2}; S.init(T.nt(), D, F.G, bx);
                S.t1 = T.f1(); S.t2 = T.f2(); S.t3 = T.f3(); S.t4 = T.f4(); S.t5 = T.f5(); S.t6 = T.f6(); S.t7 = T.f7(); S.estride = (size_t)D * DFFE * esz;
            } else {
                const unsigned char* wb = f8 ? ws + WS_W8DN + (size_t)(l >> 1) * D * DFF : ws + WS_WDN + (size_t)(l >> 1) * D * DFF * 2;
                g = pg8::Gemm{(const pg8::bf16_t*)(ar + AR_HID), (const pg8::bf16_t*)wb, M, D, DFF * esz / 2}; S.init(M / 256, D, F.G, bx);
                if (ho) S.hand = (unsigned*)(F.ctl + CW_HAND + (4 + (l >> 1)) * HAND_BANK);
            }
            if ((FP8DN & 0xF) != 0 && f8) pg8::gemm_phase<pg8::EpiCol8<0, (MK_HANDOFF != 0)>, pg8::GroupOrder, true, true, true>(F.lds, g, S, E);
            if ((FP8DN & 0xF) != 0xF && !f8) pg8::gemm_phase<pg8::EpiCol8<0, (MK_HANDOFF != 0)>, pg8::GroupOrder, true, true, false>(F.lds, g, S, E);
            if (CONV0_TAIL && l == 0) { const int nx = (M / 256) * 4 - 2 * F.G; __syncthreads(); if (nx > 0 && nx < F.G) conv_experts(F, in, 0, nx, F.G - nx); else conv_experts(F, in, 0); }
            if (!ho) PHASE_END(pb + 9);
        }
        if (RUN(pb + 10)) { const bool hi_ = MK_HANDOFF && !moe && RUN(pb + 9); const int nld = (M / 256) * 4 > 2 * F.G ? (M / 256) * 4 - 2 * F.G : 0;
            ph_end(F, in, l, xl, xc, hi_ ? F.ctl + CW_HAND + (4 + (l >> 1)) * HAND_BANK : nullptr, hi_ ? nld : 0); PHASE_END(pb + 10); }
    }
#undef RUN
#undef PHASE_END
}

extern "C" void kernel_launch(void* const* d_in, const int* in_sizes, int n_in, void* d_out, int out_size, void* d_ws, size_t ws_size, hipStream_t stream) {
    static int grid = 0;
    if (grid == 0) {
        if (n_in != 22 || in_sizes[0] != M_LAT * D || out_size != M_LAT * D || ws_size < WS_END) { fprintf(stderr, "kernel_launch: unexpected shapes (n_in %d, out %d, ws %zu < %zu); nothing launched\n", n_in, out_size, ws_size, (size_t)WS_END); grid = -1; return; }
        int dev = 0, cus = 0, per_cu = 0;
        if (hipGetDevice(&dev) != hipSuccess || hipDeviceGetAttribute(&cus, hipDeviceAttributeMultiprocessorCount, dev) != hipSuccess) { grid = -1; return; }
        if (hipFuncSetAttribute((const void*)fwd_kernel, hipFuncAttributeMaxDynamicSharedMemorySize, LDS_BYTES) != hipSuccess) { fprintf(stderr, "kernel_launch: hipFuncSetAttribute failed\n"); grid = -1; return; }
        if (hipOccupancyMaxActiveBlocksPerMultiprocessor(&per_cu, (const void*)fwd_kernel, NWAVES * 64, LDS_BYTES) != hipSuccess || per_cu < 1) { fprintf(stderr, "kernel_launch: occupancy query reports %d blocks per CU\n", per_cu); }
        (void)hipGetLastError();
        grid = cus;
        if (grid * RL_UNITS < 272 * 28) { fprintf(stderr, "kernel_launch: %d CUs: the gathered GEMM's LDS row lists are sized for >= 254 workgroups; nothing launched\n", grid); grid = -1; return; }
    }
    if (grid < 0) return;
    if (hipMemsetAsync((char*)d_ws + WS_CTL, 0, CTL_ZERO_BYTES, stream) != hipSuccess) return;
    Args a{};
    for (int i = 0; i < 22; ++i) a.in[i] = (const float*)d_in[i];
    a.out = (float*)d_out; a.ws = (unsigned char*)d_ws;
#if MK_ONE_LAUNCH
    a.ph_lo = 0; a.ph_hi = NPH;
    hipLaunchKernelGGL(fwd_kernel, dim3(grid), dim3(NWAVES * 64), LDS_BYTES, stream, a);
#else
    for (int p = 0; p < NPH; ++p) {
        const int k = (p - 1) % 11, l = (p - 1) / 11;
        if (p > 0 && ((k == 0 && l != 0) || k == 4 || k == 7)) continue;
        a.ph_lo = p; a.ph_hi = p + 1;
        hipLaunchKernelGGL(fwd_kernel, dim3(grid), dim3(NWAVES * 64), LDS_BYTES, stream, a);
    }
#endif
}
```

```cpp
#include <hip/hip_runtime.h>
#include <cstdio>
#include <cstdint>
#include <cmath>
namespace pg8 {
#define PG8_LAS __attribute__((address_space(3)))
typedef unsigned short bf16_t;
typedef short bf16x8 __attribute__((ext_vector_type(8)));
typedef float f32x4 __attribute__((ext_vector_type(4)));
typedef unsigned u32x4 __attribute__((ext_vector_type(4)));
constexpr int BM = 256, BK = 64, HALF = 128, HTB = HALF * BK * 2  , STAGE_BYTES = 8 * HTB, NXCD = 8, WGM = 8;

__host__ __device__ __forceinline__ int lds_byte(int r, int c) { const int st = (r >> 4) * 2 + (c >> 5), rr = r & 15, cc = c & 31, ob = rr * 64 + cc * 2; return st * 1024 + (ob ^ (((ob >> 9) & 1) << 5)); }
__host__ __device__ __forceinline__ void stage_rc(int b, int& R, int& C) { const int st = b / 1024, sb = b % 1024, swz = sb ^ (((sb >> 9) & 1) << 5); R = (st >> 1) * 16 + swz / 64; C = (st & 1) * 32 + (swz % 64) / 2; }
__host__ __device__ __forceinline__ int perm32(int rho) { const int n = rho >> 4, i = rho & 15; return 8 * (i >> 2) + 4 * n + (i & 3); }

struct Unit { int pm, pn; };
struct Gemm { const bf16_t* A; const bf16_t* Bt; int M, N, K; };

struct StaticOrder {
    int nM, nN, nwg, G, c;
    __host__ __device__ void init(int M, int N, int G_, int c_) { nM = M / BM; nN = N / BM; nwg = nM * nN; G = G_; c = c_; }
    __host__ __device__ bool next(int i, Unit& u) const {
        const long L = (long)i * G + c; if (L >= nwg) return false;
        int wgid = (int)L; { const int q = nwg / NXCD, r = nwg % NXCD, xcd = wgid % NXCD, off = wgid / NXCD; wgid = (xcd < r ? xcd * (q + 1) : r * (q + 1) + (xcd - r) * q) + off; }
        const int nig = WGM * nN, gid = wgid / nig, fm = gid * WGM, gsz = (nM - fm) < WGM ? (nM - fm) : WGM;
        u.pm = fm + ((wgid % nig) % gsz); u.pn = (wgid % nig) / gsz; return true;
    }
    __device__ __forceinline__ void a_ready(const Unit&) const {}
    __device__ __forceinline__ void done(const Unit&) const {}
};

__device__ __forceinline__ unsigned cvt_pk_bf16(float lo, float hi) { unsigned r; asm volatile("v_cvt_pk_bf16_f32 %0, %1, %2" : "=v"(r) : "v"(lo), "v"(hi)); return r; }
typedef float f32x2 __attribute__((ext_vector_type(2)));

#ifndef WTALL
#define WTALL 0
#endif
struct GroupOrder {
    int nM, nN, nwg, G, c;
    int t1, t2, t3, t4, t5, t6, t7;
    size_t estride;
    unsigned* hand;
    const PG8_LAS unsigned short* rl;
    __device__ __forceinline__ void init(int nM_, int N, int G_, int c_) { nM = nM_; nN = N / BM; nwg = nM * nN; G = G_; c = c_; t1 = t2 = t3 = t4 = t5 = t6 = t7 = 0x7fffffff; estride = 0; rl = nullptr; hand = nullptr; }
    __device__ __forceinline__ bool next(int i, Unit& u) const {
        const long L = (long)i * G + c; if (L >= nwg) return false;
        int wgid = (int)L; { const int q = nwg / NXCD, r = nwg % NXCD, xcd = wgid % NXCD, off = wgid / NXCD; wgid = (xcd < r ? xcd * (q + 1) : r * (q + 1) + (xcd - r) * q) + off; }
        const int nig = WGM * nN, gid = wgid / nig, fm = gid * WGM, gsz = (nM - fm) < WGM ? (nM - fm) : WGM;
        u.pm = fm + ((wgid % nig) % gsz); u.pn = (wgid % nig) / gsz; return true;
    }
    __device__ __forceinline__ const char* bbase(const Gemm& g, const Unit& u, size_t tstep) const {
        const int e = (u.pm >= t1) + (u.pm >= t2) + (u.pm >= t3) + (u.pm >= t4) + (u.pm >= t5) + (u.pm >= t6) + (u.pm >= t7);
        return (const char*)g.Bt + (size_t)e * estride + (size_t)u.pn * tstep;
    }
    __device__ __forceinline__ void a_ready(const Unit&) const {}
    __device__ __forceinline__ void done(const Unit& u) const {
        if (hand) { asm volatile("s_waitcnt vmcnt(0)" ::: "memory"); if ((threadIdx.x & 63) == 0) __hip_atomic_fetch_add(hand + 64 * u.pm, 1u, __ATOMIC_RELAXED, __HIP_MEMORY_SCOPE_AGENT); }
    }
};

typedef unsigned u32x2 __attribute__((ext_vector_type(2)));
__device__ __forceinline__ float bf_lo(unsigned w) { return __uint_as_float(w << 16); }
__device__ __forceinline__ float bf_hi(unsigned w) { return __uint_as_float(w & 0xffff0000u); }
__device__ __forceinline__ float sigmoid_f(float x) { return __builtin_amdgcn_rcpf(1.0f + __builtin_amdgcn_exp2f(-1.4426950408889634f * x)); }

struct EpiIn {
    static constexpr bool PERM = false, AFTER_DRAIN = false, ROLLOK = false; static constexpr int NST = 32;
    bf16_t* Q; bf16_t* Kb; bf16_t* VT; bf16_t* P; bf16_t* Gt; const float* rope; float c2; float us; int gate0;
    template <int ALO = 0, int AHI = 2> __device__ __forceinline__ void operator()(const f32x4 (&acc)[2][2][4][2], const Unit& u, int wr, int wc, int fr, int fq) const {
        const int row0 = u.pm * BM + wr * 64 + fr; const int pn = u.pn;
        __amdgpu_buffer_rsrc_t rsq_; if (WTALL > 1) rsq_ = __builtin_amdgcn_make_buffer_rsrc((void*)Q, 0, 0x7ffffff0, 0x00020000);
        if (pn >= 3) {
            const bool sig = pn >= gate0; bf16_t* base = sig ? Gt : P; const int ldc = sig ? 2048 : 512; const int colt = (sig ? (pn - gate0) : (pn - 3)) * 256 + wc * 32 + 4 * fq; const float cs1 = -1.4426950408889634f * us;
#pragma unroll
            for (int ai = ALO; ai < AHI; ++ai)
#pragma unroll
                for (int m = 0; m < 4; ++m) { bf16_t* rowp = base + (size_t)(row0 + ai * HALF + m * 16) * ldc + colt;
#pragma unroll
                    for (int bj = 0; bj < 2; ++bj)
#pragma unroll
                        for (int n = 0; n < 2; ++n) { f32x4 v = acc[ai][bj][m][n];
                            if (!sig) v = v * us;
                            if (sig) { const f32x4 t = v * cs1; f32x4 ex; ex[0] = __builtin_amdgcn_exp2f(t[0]); ex[1] = __builtin_amdgcn_exp2f(t[1]); ex[2] = __builtin_amdgcn_exp2f(t[2]); ex[3] = __builtin_amdgcn_exp2f(t[3]);
                                const f32x4 den = ex + 1.0f; v[0] = __builtin_amdgcn_rcpf(den[0]); v[1] = __builtin_amdgcn_rcpf(den[1]); v[2] = __builtin_amdgcn_rcpf(den[2]); v[3] = __builtin_amdgcn_rcpf(den[3]); }
                            u32x2 w; w.x = cvt_pk_bf16(v[0], v[1]); w.y = cvt_pk_bf16(v[2], v[3]); *(u32x2*)(rowp + bj * HALF + n * 16) = w; } }
        } else {
            const bool lat = u.pm < 128;
#pragma unroll
            for (int ai = ALO; ai < AHI; ++ai)
#pragma unroll
                for (int m = 0; m < 4; ++m) { const int row = row0 + ai * HALF + m * 16; const int t = row & 8191; const int pos = (wc & 1) ? (t & 63) : (t >> 6);
                    f32x4 cs = (f32x4){1.f, 1.f, 1.f, 1.f}, sn = (f32x4){0.f, 0.f, 0.f, 0.f};
                    if (lat) { cs = *(const f32x4*)(rope + pos * 32 + 4 * fq); sn = *(const f32x4*)(rope + pos * 32 + 16 + 4 * fq); }
#pragma unroll
                    for (int bj = 0; bj < 2; ++bj) { const f32x4 x1 = acc[ai][bj][m][0] * us, x2 = acc[ai][bj][m][1] * us;
                        if (pn == 2 && bj == 1) {
                            const int rc = row - 32768; const int b = lat ? (row >> 13) : (rc >> 8); const int kk = lat ? t : 8192 + (rc & 255);
                            bf16_t* vp = VT + ((size_t)((b * 2 + (wc >> 1)) * 64 + 32 * (wc & 1) + 4 * fq)) * 8448 + kk;
#pragma unroll
                            for (int j = 0; j < 4; ++j) { vp[(size_t)j * 8448] = (bf16_t)(cvt_pk_bf16(x1[j], 0.f) & 0xffffu); vp[(size_t)(16 + j) * 8448] = (bf16_t)(cvt_pk_bf16(x2[j], 0.f) & 0xffffu); }
                        } else {
                            f32x4 o1 = x1 * cs - x2 * sn, o2 = x2 * cs + x1 * sn; bf16_t* dst;
                            if (pn < 2) { o1 = o1 * c2; o2 = o2 * c2; dst = Q + (size_t)row * 512 + pn * 256 + bj * HALF + wc * 32 + 4 * fq; }
                            else dst = Kb + (size_t)row * 128 + wc * 32 + 4 * fq;
                            u32x2 w; w.x = cvt_pk_bf16(o1[0], o1[1]); w.y = cvt_pk_bf16(o1[2], o1[3]); u32x2 w2; w2.x = cvt_pk_bf16(o2[0], o2[1]); w2.y = cvt_pk_bf16(o2[2], o2[3]);
                            if (WTALL > 1 && pn < 2) { const unsigned ob = (unsigned)((const char*)dst - (const char*)Q); __builtin_amdgcn_raw_buffer_store_b64(w, rsq_, ob, 0, 16); __builtin_amdgcn_raw_buffer_store_b64(w2, rsq_, ob + 32, 0, 16); }
                            else { *(u32x2*)dst = w; *(u32x2*)(dst + 16) = w2; }
                        } } }
        }
    }
};

__device__ __forceinline__ unsigned pack_fp8x4(float a, float b, float c, float d) {
    a = __builtin_amdgcn_fmed3f(a, -448.f, 448.f); b = __builtin_amdgcn_fmed3f(b, -448.f, 448.f); c = __builtin_amdgcn_fmed3f(c, -448.f, 448.f); d = __builtin_amdgcn_fmed3f(d, -448.f, 448.f);
    int r = 0; r = __builtin_amdgcn_cvt_pk_fp8_f32(a, b, r, false); r = __builtin_amdgcn_cvt_pk_fp8_f32(c, d, r, true); return (unsigned)r; }
template <int MODE, bool WT = (WTALL != 0)> struct EpiCol8 {
    static constexpr bool PERM = true, AFTER_DRAIN = false, ROLLOK = true; static constexpr int NST = 16;
    bf16_t* O; int ldo; const bf16_t* Gt; int goff; const bf16_t* T; const float* vec; float oscale;
    template <int ALO = 0, int AHI = 2> __device__ __forceinline__ void operator()(const f32x4 (&acc)[2][2][4][2], const Unit& u, int wr, int wc, int fr, int fq) const {
        const int row0 = u.pm * BM + wr * 64 + fr, col0 = u.pn * BM + wc * 32 + 8 * fq;
        f32x4 sv[2][2];
        __amdgpu_buffer_rsrc_t rsrc_; if (WT) rsrc_ = __builtin_amdgcn_make_buffer_rsrc((void*)O, 0, 0x7ffffff0, 0x00020000);
        if (MODE == 3) {
#pragma unroll
            for (int bj = 0; bj < 2; ++bj)
#pragma unroll
                for (int n = 0; n < 2; ++n) sv[bj][n] = *(const f32x4*)(vec + col0 + bj * HALF + 4 * n);
        }
#pragma unroll
        for (int ai = ALO; ai < AHI; ++ai)
#pragma unroll
            for (int m = 0; m < 4; ++m) { const size_t row = (size_t)(row0 + ai * HALF + m * 16);
#pragma unroll
                for (int bj = 0; bj < 2; ++bj) { const int col = col0 + bj * HALF; f32x4 v0 = acc[ai][bj][m][0], v1 = acc[ai][bj][m][1];
                    if (MODE == 1 || MODE == 2 || MODE == 4) { const u32x4 g = *(const u32x4*)(Gt + row * 2048 + goff + col);
                        v0[0] *= bf_lo(g.x); v0[1] *= bf_hi(g.x); v0[2] *= bf_lo(g.y); v0[3] *= bf_hi(g.y); v1[0] *= bf_lo(g.z); v1[1] *= bf_hi(g.z); v1[2] *= bf_lo(g.w); v1[3] *= bf_hi(g.w); }
                    if (MODE == 2 || MODE == 4) { const u32x4 t = *(const u32x4*)(T + row * 1024 + col);
                        v0[0] += bf_lo(t.x); v0[1] += bf_hi(t.x); v0[2] += bf_lo(t.y); v0[3] += bf_hi(t.y); v1[0] += bf_lo(t.z); v1[1] += bf_hi(t.z); v1[2] += bf_lo(t.w); v1[3] += bf_hi(t.w); }
                    if (MODE == 3) { v0 = v0 * sv[bj][0]; v1 = v1 * sv[bj][1]; }
                    if (MODE == 0) { v0 = v0 * oscale; v1 = v1 * oscale; }
                    if (MODE == 4) { u32x2 w8; w8.x = pack_fp8x4(v0[0] * oscale, v0[1] * oscale, v0[2] * oscale, v0[3] * oscale); w8.y = pack_fp8x4(v1[0] * oscale, v1[1] * oscale, v1[2] * oscale, v1[3] * oscale);
                        *(u32x2*)((unsigned char*)O + row * ldo + col) = w8; continue; }
                    u32x4 w; w.x = cvt_pk_bf16(v0[0], v0[1]); w.y = cvt_pk_bf16(v0[2], v0[3]); w.z = cvt_pk_bf16(v1[0], v1[1]); w.w = cvt_pk_bf16(v1[2], v1[3]);
                    if (WT) __builtin_amdgcn_raw_buffer_store_b128(w, rsrc_, (unsigned)((row * ldo + col) * 2), 0, 16); else *(u32x4*)(O + row * ldo + col) = w; } }
    }
};

struct EpiGate8 {
    static constexpr bool PERM = true, AFTER_DRAIN = false, ROLLOK = true; static constexpr int NST = 16;
    bf16_t* Gt; float unscale;
    template <int ALO = 0, int AHI = 2> __device__ __forceinline__ void operator()(const f32x4 (&acc)[2][2][4][2], const Unit& u, int wr, int wc, int fr, int fq) const {
        const int row0 = u.pm * BM + wr * 64 + fr, col0 = u.pn * BM + wc * 32 + 8 * fq; const float c1 = -1.4426950408889634f * unscale;
#pragma unroll
        for (int ai = ALO; ai < AHI; ++ai)
#pragma unroll
            for (int m = 0; m < 4; ++m) { const size_t row = (size_t)(row0 + ai * HALF + m * 16);
#pragma unroll
                for (int bj = 0; bj < 2; ++bj) { f32x4 s[2];
#pragma unroll
                    for (int n = 0; n < 2; ++n) { const f32x4 t = acc[ai][bj][m][n] * c1; f32x4 ex; ex[0] = __builtin_amdgcn_exp2f(t[0]); ex[1] = __builtin_amdgcn_exp2f(t[1]); ex[2] = __builtin_amdgcn_exp2f(t[2]); ex[3] = __builtin_amdgcn_exp2f(t[3]);
                        const f32x4 den = ex + 1.0f; s[n][0] = __builtin_amdgcn_rcpf(den[0]); s[n][1] = __builtin_amdgcn_rcpf(den[1]); s[n][2] = __builtin_amdgcn_rcpf(den[2]); s[n][3] = __builtin_amdgcn_rcpf(den[3]); }
                    u32x4 w; w.x = cvt_pk_bf16(s[0][0], s[0][1]); w.y = cvt_pk_bf16(s[0][2], s[0][3]); w.z = cvt_pk_bf16(s[1][0], s[1][1]); w.w = cvt_pk_bf16(s[1][2], s[1][3]);
                    if (WTALL) { unsigned long long* gp = (unsigned long long*)(Gt + row * 2048 + col0 + bj * HALF);
                        __hip_atomic_store(gp, ((unsigned long long)w.y << 32) | (unsigned long long)w.x, __ATOMIC_RELAXED, __HIP_MEMORY_SCOPE_AGENT); __hip_atomic_store(gp + 1, ((unsigned long long)w.w << 32) | (unsigned long long)w.z, __ATOMIC_RELAXED, __HIP_MEMORY_SCOPE_AGENT); }
                    else *(u32x4*)(Gt + row * 2048 + col0 + bj * HALF) = w; } }
    }
};


template <bool FP8, bool FP8OUT> struct EpiSwiglu {
    static constexpr bool PERM = true, AFTER_DRAIN = false, ROLLOK = true; static constexpr int NST = 8;
    void* H; int ldh; float unscale, hscale;
    template <int ALO = 0, int AHI = 2> __device__ __forceinline__ void operator()(const f32x4 (&acc)[2][2][4][2], const Unit& u, int wr, int wc, int fr, int fq) const {
        const int row0 = u.pm * BM + wr * 64 + fr, col0 = u.pn * HALF + wc * 32 + 8 * fq;
        const float c1 = -1.4426950408889634f * (FP8 ? unscale : 1.0f), c2 = (FP8 ? unscale * unscale : 1.0f) * (FP8OUT ? hscale : 1.0f);
#pragma unroll
        for (int ai = ALO; ai < AHI; ++ai)
#pragma unroll
            for (int m = 0; m < 4; ++m) { const size_t row = (size_t)(row0 + ai * HALF + m * 16); f32x4 h[2];
#pragma unroll
                for (int n = 0; n < 2; ++n) { const f32x4 gt = acc[ai][0][m][n], up = acc[ai][1][m][n];
                    const f32x4 t = gt * c1; f32x4 ex; ex[0] = __builtin_amdgcn_exp2f(t[0]); ex[1] = __builtin_amdgcn_exp2f(t[1]); ex[2] = __builtin_amdgcn_exp2f(t[2]); ex[3] = __builtin_amdgcn_exp2f(t[3]);
                    const f32x4 den = ex + 1.0f; f32x4 r; r[0] = __builtin_amdgcn_rcpf(den[0]); r[1] = __builtin_amdgcn_rcpf(den[1]); r[2] = __builtin_amdgcn_rcpf(den[2]); r[3] = __builtin_amdgcn_rcpf(den[3]);
                    f32x4 p = gt * up; p = p * r; if (FP8 || FP8OUT) p = p * c2; h[n] = p; }
                if (FP8OUT) { u32x2 w; w.x = pack_fp8x4(h[0][0], h[0][1], h[0][2], h[0][3]); w.y = pack_fp8x4(h[1][0], h[1][1], h[1][2], h[1][3]); if (WTALL) __hip_atomic_store((unsigned long long*)((unsigned char*)H + row * ldh + col0), ((unsigned long long)w.y << 32) | (unsigned long long)w.x, __ATOMIC_RELAXED, __HIP_MEMORY_SCOPE_AGENT); else *(u32x2*)((unsigned char*)H + row * ldh + col0) = w; }
                else { u32x4 w; w.x = cvt_pk_bf16(h[0][0], h[0][1]); w.y = cvt_pk_bf16(h[0][2], h[0][3]); w.z = cvt_pk_bf16(h[1][0], h[1][1]); w.w = cvt_pk_bf16(h[1][2], h[1][3]);
                    *(u32x4*)((bf16_t*)H + row * ldh + col0) = w; } }
    }
};

template <class Epi, class Sched, bool ALIGN_EPI = false, bool SP2 = false, bool FP8 = false, bool GATHER = false>
__device__ __forceinline__ void gemm_phase(PG8_LAS unsigned char* lds, const Gemm g, const Sched& S, const Epi& E) {
    int tid_ = threadIdx.x; asm volatile("" : "+v"(tid_)); const int tid = tid_, wid = __builtin_amdgcn_readfirstlane(tid >> 6), lane = tid & 63, wr = wid >> 2, wc = wid & 3, fr = lane & 15, fq = lane >> 4;
    const int K = g.K, nt = K / BK;
    unsigned voffA[2], voffB[2]; int rowA[2]; unsigned colA2[2]; unsigned vA[2][2], vAn[2][2]; bool last_ = false; (void)rowA; (void)colA2; (void)vA; (void)vAn; (void)last_;
#pragma unroll
    for (int i = 0; i < 2; ++i) { int R, C; stage_rc(tid * 16 + i * 8192, R, C); const int Rb = Epi::PERM ? ((R & ~31) + perm32(R & 31)) : R;
        voffA[i] = (unsigned)(R * K + C) * 2u; voffB[i] = (unsigned)(Rb * K + C) * 2u; rowA[i] = R; colA2[i] = (unsigned)C * 2u; }
    const size_t kstep = (size_t)(BK * 2);
    const size_t hstep = (size_t)HALF * K * 2;
    const size_t tstep = 2 * hstep;
    const unsigned ldsw = (unsigned)wid * 1024u;
    const int aoff = lds_byte(wr * 64 + fr, fq * 8), boff = lds_byte(wc * 32 + fr, fq * 8);
#define PG8_SA(b, h) (((b) * 2 + (h)) * HTB)
#define PG8_SB(b, h) ((4 + (b) * 2 + (h)) * HTB)
#define PG8_STAGE(bufoff, gbase, voff) do { _Pragma("unroll") for (int _i = 0; _i < 2; ++_i) \
        __builtin_amdgcn_global_load_lds((const unsigned*)((const char*)(gbase) + (voff)[_i]), (PG8_LAS unsigned*)(lds + (bufoff) + ldsw + _i * 8192), 16, 0, 0); } while (0)
#define PG8_STAGE_A(bufoff, base, half, nx) do { if constexpr (GATHER) { unsigned vsel_[2]; vsel_[0] = ((nx) && last_) ? vAn[half][0] : vA[half][0]; vsel_[1] = ((nx) && last_) ? vAn[half][1] : vA[half][1]; PG8_STAGE(bufoff, base, vsel_); } \
        else { PG8_STAGE(bufoff, (base) + (half) * hstep, voffA); } } while (0)
#define PG8_LDA(dst, b, h) do { _Pragma("unroll") for (int m = 0; m < 4; ++m) { if constexpr (FP8) { const v4i_ lo_ = *(const PG8_LAS v4i_*)(lds + PG8_SA(b, h) + aoff + m * 2048), hi_ = *(const PG8_LAS v4i_*)(lds + PG8_SA(b, h) + aoff + m * 2048 + 1024); \
        dst##8[m] = __builtin_shufflevector(lo_, hi_, 0, 1, 2, 3, 4, 5, 6, 7); } else { _Pragma("unroll") for (int k = 0; k < 2; ++k) dst[m][k] = *(const PG8_LAS bf16x8*)(lds + PG8_SA(b, h) + aoff + m * 2048 + k * 1024); } } } while (0)
#define PG8_LDB(dst, b, h) do { _Pragma("unroll") for (int n = 0; n < 2; ++n) { if constexpr (FP8) { const v4i_ lo_ = *(const PG8_LAS v4i_*)(lds + PG8_SB(b, h) + boff + n * 2048), hi_ = *(const PG8_LAS v4i_*)(lds + PG8_SB(b, h) + boff + n * 2048 + 1024); \
        dst##8[n] = __builtin_shufflevector(lo_, hi_, 0, 1, 2, 3, 4, 5, 6, 7); } else { _Pragma("unroll") for (int k = 0; k < 2; ++k) dst[n][k] = *(const PG8_LAS bf16x8*)(lds + PG8_SB(b, h) + boff + n * 2048 + k * 1024); } } } while (0)
#define PG8_MMA(ai, bj, At, Bt) do { __builtin_amdgcn_s_setprio(1); _Pragma("unroll") for (int m = 0; m < 4; ++m) _Pragma("unroll") for (int n = 0; n < 2; ++n) { \
        if constexpr (FP8) { asm volatile("v_mfma_f32_16x16x128_f8f6f4 %0, %1, %2, %0" : "+v"(acc[ai][bj][m][n]) : "v"(Bt##8[n]), "v"(At##8[m])); } \
        else { _Pragma("unroll") for (int k = 0; k < 2; ++k) acc[ai][bj][m][n] = __builtin_amdgcn_mfma_f32_16x16x32_bf16(Bt[n][k], At[m][k], acc[ai][bj][m][n], 0, 0, 0); } } \
        __builtin_amdgcn_s_setprio(0); } while (0)
#define PG8_WAIT_V(n) asm volatile("s_waitcnt vmcnt(" #n ")" ::: "memory")
#define PG8_WAIT_L(n) asm volatile("s_waitcnt lgkmcnt(" #n ")" ::: "memory")
#define PG8_BAR __builtin_amdgcn_s_barrier()
#define PG8_SCHED __builtin_amdgcn_sched_barrier(0)
    Unit cur, nxt; int ui = 0;
    if (!S.next(0, cur)) return;
    f32x4 acc[2][2][4][2];
#pragma unroll
    for (int a = 0; a < 2; ++a)
#pragma unroll
        for (int b = 0; b < 2; ++b)
#pragma unroll
            for (int m = 0; m < 4; ++m)
#pragma unroll
                for (int n = 0; n < 2; ++n) acc[a][b][m][n] = (f32x4){0.f, 0.f, 0.f, 0.f};
    typedef int v4i_ __attribute__((ext_vector_type(4))); typedef int v8i_ __attribute__((ext_vector_type(8)));
    bf16x8 At[4][2], B0[2][2], B1[2][2]; v8i_ At8[4], B08[2], B18[2];
    (void)At; (void)B0; (void)B1; (void)At8; (void)B08; (void)B18;
    const char* cA = GATHER ? (const char*)g.A : (const char*)g.A + (size_t)cur.pm * tstep; const char* cB = S.bbase(g, cur, tstep);
#define PG8_ROWS(dst, uidx) do { const PG8_LAS unsigned short* rl_ = S.rl + (uidx) * 256; _Pragma("unroll") for (int h_ = 0; h_ < 2; ++h_) _Pragma("unroll") for (int i_ = 0; i_ < 2; ++i_) \
        dst[h_][i_] = (unsigned)rl_[h_ * HALF + rowA[i_]] * (unsigned)(K * 2) + colA2[i_]; } while (0)
    if constexpr (GATHER) { PG8_ROWS(vA, 0); _Pragma("unroll") for (int h_ = 0; h_ < 2; ++h_) { vAn[h_][0] = vA[h_][0]; vAn[h_][1] = vA[h_][1]; } }
    S.a_ready(cur);
    if constexpr (SP2) {
        PG8_STAGE(PG8_SB(0, 0), cB, voffB); PG8_STAGE(PG8_SB(0, 1), cB + hstep, voffB); PG8_STAGE_A(PG8_SA(0, 0), cA, 0, 0); PG8_STAGE_A(PG8_SA(0, 1), cA, 1, 0);
        if (wr == 1) PG8_BAR;
        PG8_WAIT_V(2); PG8_BAR;
        PG8_STAGE(PG8_SB(1, 0), cB + kstep, voffB); PG8_STAGE_A(PG8_SA(1, 0), cA + kstep, 0, 0); PG8_STAGE(PG8_SB(1, 1), cB + hstep + kstep, voffB);
        PG8_WAIT_V(6); PG8_BAR;
    } else {
        PG8_STAGE(PG8_SB(0, 0), cB, voffB); PG8_STAGE_A(PG8_SA(0, 0), cA, 0, 0); PG8_STAGE(PG8_SB(0, 1), cB + hstep, voffB); PG8_STAGE_A(PG8_SA(0, 1), cA, 1, 0);
        if (wr == 1) PG8_BAR;
        PG8_WAIT_V(4); PG8_BAR;
        PG8_STAGE(PG8_SB(1, 0), cB + kstep, voffB); PG8_STAGE_A(PG8_SA(1, 0), cA + kstep, 0, 0); PG8_STAGE(PG8_SB(1, 1), cB + hstep + kstep, voffB);
        PG8_WAIT_V(6); PG8_BAR;
    }
    for (;;) {
        const bool has_next = S.next(ui + 1, nxt);
        const char* nA = (has_next && !GATHER) ? (const char*)g.A + (size_t)nxt.pm * tstep : cA; const char* nB = has_next ? S.bbase(g, nxt, tstep) : cB;
        if constexpr (GATHER) { if (has_next) PG8_ROWS(vAn, ui + 1); }
        for (int t = 0; t < nt; t += 2) {
            const bool last = (t == nt - 2); last_ = last;
            const char* a1 = cA + (size_t)(t + 1) * kstep;
            const char* a2 = last ? nA : cA + (size_t)(t + 2) * kstep; const char* b2 = last ? nB : cB + (size_t)(t + 2) * kstep;
            const char* a3 = a2 + kstep; const char* b3 = b2 + kstep;
            if (last && has_next) S.a_ready(nxt);
            if constexpr (SP2) {
            PG8_LDB(B0, 0, 0); PG8_LDB(B1, 0, 1); PG8_SCHED; PG8_LDA(At, 0, 0); PG8_STAGE_A(PG8_SA(1, 1), a1, 1, 0);
            PG8_WAIT_V(8); PG8_WAIT_L(0); PG8_BAR; PG8_MMA(0, 0, At, B0); PG8_MMA(0, 1, At, B1); PG8_BAR; PG8_SCHED;
            PG8_LDA(At, 0, 1); PG8_STAGE(PG8_SB(0, 0), b2, voffB); PG8_STAGE(PG8_SB(0, 1), b2 + hstep, voffB); PG8_STAGE_A(PG8_SA(0, 0), a2, 0, 1);
            PG8_WAIT_V(8); PG8_WAIT_L(0); PG8_BAR; PG8_MMA(1, 0, At, B0); PG8_MMA(1, 1, At, B1); PG8_BAR; PG8_SCHED;
            PG8_LDB(B0, 1, 0); PG8_LDB(B1, 1, 1); PG8_SCHED; PG8_LDA(At, 1, 0); PG8_STAGE_A(PG8_SA(0, 1), a2, 1, 1);
            PG8_WAIT_V(8); PG8_WAIT_L(0); PG8_BAR; PG8_MMA(0, 0, At, B0); PG8_MMA(0, 1, At, B1); PG8_BAR; PG8_SCHED;
            PG8_LDA(At, 1, 1); PG8_STAGE(PG8_SB(1, 0), b3, voffB); PG8_STAGE(PG8_SB(1, 1), b3 + hstep, voffB); PG8_STAGE_A(PG8_SA(1, 0), a3, 0, 1);
            PG8_WAIT_V(8); PG8_WAIT_L(0); PG8_BAR; PG8_MMA(1, 0, At, B0); PG8_MMA(1, 1, At, B1); PG8_BAR; PG8_SCHED;
            } else {
            PG8_LDB(B0, 0, 0); PG8_SCHED; PG8_LDA(At, 0, 0); PG8_STAGE_A(PG8_SA(1, 1), a1, 1, 0);
            PG8_WAIT_L(8); PG8_BAR; PG8_WAIT_L(0); PG8_MMA(0, 0, At, B0); PG8_BAR; PG8_SCHED;
            PG8_LDB(B1, 0, 1); PG8_STAGE(PG8_SB(0, 0), b2, voffB);
            PG8_BAR; PG8_WAIT_L(0); PG8_MMA(0, 1, At, B1); PG8_BAR;
            PG8_LDA(At, 0, 1); PG8_STAGE_A(PG8_SA(0, 0), a2, 0, 1);
            PG8_BAR; PG8_WAIT_L(0); PG8_MMA(1, 0, At, B0); PG8_BAR; PG8_SCHED;
            PG8_STAGE(PG8_SB(0, 1), b2 + hstep, voffB);
            PG8_WAIT_V(6); PG8_BAR; PG8_MMA(1, 1, At, B1); PG8_BAR;
            PG8_LDB(B0, 1, 0); PG8_SCHED; PG8_LDA(At, 1, 0); PG8_STAGE_A(PG8_SA(0, 1), a2, 1, 1);
            PG8_WAIT_L(8); PG8_BAR; PG8_WAIT_L(0); PG8_MMA(0, 0, At, B0); PG8_BAR; PG8_SCHED;
            PG8_LDB(B1, 1, 1); PG8_STAGE(PG8_SB(1, 0), b3, voffB);
            PG8_BAR; PG8_WAIT_L(0); PG8_MMA(0, 1, At, B1); PG8_BAR;
            PG8_LDA(At, 1, 1); PG8_STAGE_A(PG8_SA(1, 0), a3, 0, 1);
            PG8_BAR; PG8_WAIT_L(0); PG8_MMA(1, 0, At, B0); PG8_BAR; PG8_SCHED;
            PG8_STAGE(PG8_SB(1, 1), b3 + hstep, voffB);
            PG8_WAIT_V(6); PG8_BAR; PG8_MMA(1, 1, At, B1); PG8_BAR;
            }
        }
        if constexpr (FP8) asm volatile("s_nop 15\n\ts_nop 7" : "+v"(acc[1][1][0][0]), "+v"(acc[1][1][0][1]), "+v"(acc[1][1][1][0]), "+v"(acc[1][1][1][1]), "+v"(acc[1][1][2][0]), "+v"(acc[1][1][2][1]), "+v"(acc[1][1][3][0]), "+v"(acc[1][1][3][1]));
        if constexpr (ALIGN_EPI) { if (wr == 0) PG8_BAR; }
        if constexpr (!Epi::AFTER_DRAIN) { E(acc, cur, wr, wc, fr, fq); S.done(cur); }
        if (!has_next) break;
#pragma unroll
        for (int a = 0; a < 2; ++a)
#pragma unroll
            for (int b = 0; b < 2; ++b)
#pragma unroll
                for (int m = 0; m < 4; ++m)
#pragma unroll
                    for (int n = 0; n < 2; ++n) acc[a][b][m][n] = (f32x4){0.f, 0.f, 0.f, 0.f};
        cur = nxt; cA = nA; cB = nB; ++ui;
        if constexpr (GATHER) { _Pragma("unroll") for (int h_ = 0; h_ < 2; ++h_) { vA[h_][0] = vAn[h_][0]; vA[h_][1] = vAn[h_][1]; } }
        if constexpr (ALIGN_EPI) { if (wr == 1) PG8_BAR; }
    }
    PG8_WAIT_V(0);
    if constexpr (!ALIGN_EPI) { if (wr == 0) PG8_BAR; }
    PG8_BAR;
    if constexpr (Epi::AFTER_DRAIN) { E.fused(acc, cur, wr, wc, fr, fq, lds, wid, lane); S.done(cur); }
#undef PG8_SA
#undef PG8_SB
#undef PG8_STAGE
#undef PG8_STAGE_A
#undef PG8_ROWS
#undef PG8_LDA
#undef PG8_LDB
#undef PG8_MMA
#undef PG8_WAIT_V
#undef PG8_WAIT_L
#undef PG8_BAR
#undef PG8_SCHED
}
}

constexpr int D = 1024, SEQ = 8192, DEPTH = 4, CTXL = 256;
constexpr int M_LAT = 32768, M_CTX = 1024, M = M_LAT + M_CTX;
constexpr int INW = 3328, DFF = 2816, NEXP = 8, DFFE = 3584;
constexpr int MP = 69632;
constexpr int VTP = SEQ + CTXL;
constexpr float EPS = 1e-6f;
constexpr float C2 = 0.125f * 1.4426950408889634f;
#ifndef FP8MASK
#define FP8MASK 0xF
#endif
constexpr float WSC = 128.f, ASC = 16.f, HSC = 8.f;
#ifndef FP8DN
#define FP8DN 0xF
#endif
__host__ __device__ constexpr bool gu_fp8(int l) { return ((FP8MASK >> l) & 1) != 0; }
__host__ __device__ constexpr bool dn_fp8(int l) { return ((FP8DN >> l) & 1) != 0; }
constexpr bool any_combo(bool gi, bool dn) { return (gu_fp8(0) == gi && dn_fp8(0) == dn) || (gu_fp8(1) == gi && dn_fp8(1) == dn) || (gu_fp8(2) == gi && dn_fp8(2) == dn) || (gu_fp8(3) == gi && dn_fp8(3) == dn); }
constexpr int NPH = 1 + 11 * DEPTH;

constexpr size_t MiB = 1u << 20;
constexpr size_t WS_CTL = 0, CTL_ZERO_BYTES = 1 * MiB;
constexpr size_t WS_MOD = 1 * MiB;
constexpr size_t WS_ROPE = 1 * MiB + 512 * 1024;
constexpr size_t WS_TOKSLOT = 2 * MiB;
constexpr size_t WS_TOKW = 2 * MiB + 512 * 1024;
constexpr size_t WS_LIST = 3 * MiB;
constexpr size_t WS_CTXS = 5 * MiB;
constexpr size_t WS_WIN = 9 * MiB, WS_WAO = 35 * MiB, WS_WPM = 39 * MiB, WS_WPO = 41 * MiB, WS_WOUT = 45 * MiB, WS_WGU = 53 * MiB, WS_WDN = 75 * MiB, WS_WEGU = 86 * MiB, WS_WEDN = 198 * MiB;
constexpr size_t WS_W8GU = 254 * MiB, WS_W8DN = 265 * MiB;
constexpr size_t WS_XN = 271 * MiB;
#ifndef XBF16
#define XBF16 1
#endif
constexpr size_t WS_XB = 337 * MiB;
constexpr size_t WS_AR = (XBF16 ? 403 : 337) * MiB;
constexpr size_t AR_Q = 0, AR_K = 33 * MiB, AR_VT = AR_K + 8 * MiB + 256 * 1024, AR_P = AR_VT + 8 * MiB + 256 * 1024, AR_G = AR_P + 33 * MiB, AR_ATT = AR_G + 132 * MiB, AR_POOLED = AR_ATT + 33 * MiB,
                 AR_MIX = AR_POOLED + 33 * MiB, AR_T1 = AR_MIX + 33 * MiB, AR_MERGED = AR_T1 + 66 * MiB, AR_Y = AR_MERGED + 66 * MiB;
#ifndef GATE8
#define GATE8 1
#endif
#ifndef QKV8
#define QKV8 1
#endif
static_assert(!QKV8 || GATE8, "QKV8 builds on the fp8 gate-logit GEMM");
#ifndef PF8
#define PF8 0
#endif
static_assert(!PF8 || QKV8, "PF8 builds on QKV8");
#ifndef CONV0_TAIL
#define CONV0_TAIL 0
#endif
#ifndef WOUT8
#define WOUT8 1
#endif
#ifndef QKV1
#define QKV1 0
#endif
constexpr int NQKVP = 1280;
constexpr size_t AR_XN8 = 520 * MiB;
constexpr size_t AR_XF = 0;
constexpr size_t AR_XG = 0, AR_HID = 136 * MiB;
constexpr size_t WS_END = WS_AR + 612 * MiB;
static_assert(AR_XN8 + (size_t)M * D <= 612 * MiB && AR_XN8 >= AR_Y + 66 * MiB && AR_HID + (size_t)M * DFF * 2 <= AR_XN8 && (!GATE8 || (dn_fp8(1) && dn_fp8(3))), "XN8 placement");
static_assert(AR_Y + 66 * MiB <= 612 * MiB && AR_HID + (size_t)MP * DFFE * 2 <= 612 * MiB && (size_t)MP * D * 2 <= AR_HID, "arena");
static_assert(WS_WIN + (size_t)4 * INW * D * 2 <= WS_WAO && WS_WGU + (size_t)2 * 2 * DFF * D * 2 <= WS_WDN && WS_WDN + (size_t)2 * DFF * D * 2 <= WS_WEGU &&
              WS_WEGU + (size_t)8 * 2 * DFFE * D * 2 <= WS_WEDN && WS_WEDN + (size_t)8 * DFFE * D * 2 <= WS_W8GU && WS_W8GU + (size_t)2 * 2 * DFF * D <= WS_W8DN && WS_W8DN + (size_t)2 * DFF * D <= WS_XN && WS_XN + (size_t)M * D * 2 <= WS_AR && AR_XF + (size_t)M * D * 2 <= AR_HID, "ws map");
constexpr int CW_BAR = 4096;
constexpr int CW_HAND = 32768, HAND_BANK = 132 * 64;
constexpr int CW_FILL = 16384;
constexpr int RING_BYTES = 131072, LDSCTL_OFF = RING_BYTES, MISC_OFF = LDSCTL_OFF + 320, RL_OFF = LDSCTL_OFF + 1024, RL_UNITS = 30, LDS_BYTES = 147456;
static_assert(RL_OFF + RL_UNITS * 512 <= LDS_BYTES, "LDS map");
constexpr int NWAVES = 8;

#define GAS __attribute__((address_space(1)))
#define LAS __attribute__((address_space(3)))
typedef unsigned short bf16;
typedef unsigned v4u __attribute__((ext_vector_type(4)));
typedef unsigned v2u __attribute__((ext_vector_type(2)));
typedef float f32x4 __attribute__((ext_vector_type(4)));
typedef float f32x2 __attribute__((ext_vector_type(2)));
typedef float f32x16 __attribute__((ext_vector_type(16)));
typedef short bf16x8 __attribute__((ext_vector_type(8)));
typedef short s16x4 __attribute__((ext_vector_type(4)));
typedef GAS unsigned gu32;
#define RLX_AGENT __ATOMIC_RELAXED, __HIP_MEMORY_SCOPE_AGENT
#define LDS_WAIT() asm volatile("s_waitcnt lgkmcnt(0)" ::: "memory")
#define VM_WAIT() asm volatile("s_waitcnt vmcnt(0)" ::: "memory")
__device__ __forceinline__ unsigned pk2(float lo, float hi) { return pg8::cvt_pk_bf16(lo, hi); }
__device__ __forceinline__ float bflo(unsigned w) { return __uint_as_float(w << 16); }
__device__ __forceinline__ float bfhi(unsigned w) { return __uint_as_float(w & 0xffff0000u); }
__device__ __forceinline__ float fast_exp(float x) { return __builtin_amdgcn_exp2f(1.4426950408889634f * x); }

#define XB_TMO      128
#define XB_XCNT(j)  (256  + 64 * (j))
#define XB_XSUB(j)  (1280 + 64 * (j))
#define XB_XGEN(j)  (2304 + 64 * (j))
#define XB_TOP      3328
#define XB_TOPGEN   3392
#define XCD_BAR_WORDS 3456
#define XB_SPIN_CAP (1u << 18)

__device__ __forceinline__ unsigned xb_ld(unsigned* p)              { return __hip_atomic_load(p, __ATOMIC_RELAXED, __HIP_MEMORY_SCOPE_AGENT); }
__device__ __forceinline__ unsigned xb_add(unsigned* p, unsigned v) { return __hip_atomic_fetch_add(p, v, __ATOMIC_RELAXED, __HIP_MEMORY_SCOPE_AGENT); }
__device__ __forceinline__ unsigned xb_xcc_id() { return (unsigned)__builtin_amdgcn_s_getreg((3 << 11) | 20) & 0xFu; }
#define XB_SPIN(cond, bar) do { unsigned _sp = 0; while (cond) { __builtin_amdgcn_s_sleep(1); \
    if ((++_sp & 255u) == 0u) { if (xb_ld(&(bar)[XB_TMO])) break; if (_sp > XB_SPIN_CAP) { atomicAdd(&(bar)[XB_TMO], 1u); break; } } } } while (0)

struct XcdBarrier {
    unsigned* bar; unsigned x;
    volatile LAS unsigned* st;
};

__device__ __forceinline__ XcdBarrier xcd_barrier_post(unsigned* bar, volatile LAS unsigned* st) {
    XcdBarrier b; b.bar = bar; b.x = xb_xcc_id(); b.st = st;
    if (threadIdx.x == 0) (void)xb_add(&bar[XB_XCNT(b.x)], 1u);
    return b;
}
__device__ __forceinline__ void xcd_barrier_complete(unsigned* bar, unsigned x, unsigned& nloc, unsigned& nx) {
    const unsigned G = gridDim.x * gridDim.y * gridDim.z;
    unsigned sum, cnt, mine, sp = 0u;
    for (;;) {
        sum = 0u; cnt = 0u; mine = 0u;
#pragma unroll
        for (unsigned j = 0; j < 16; ++j) { const unsigned c = xb_ld(&bar[XB_XCNT(j)]); sum += c; cnt += (c > 0u) ? 1u : 0u; mine = (j == x) ? c : mine; }
        if (sum == G) break;
        __builtin_amdgcn_s_sleep(1);
        if ((++sp & 255u) == 0u) { if (xb_ld(&bar[XB_TMO])) break; if (sp > XB_SPIN_CAP) { atomicAdd(&bar[XB_TMO], 1u); break; } }
    }
    nloc = mine > 0u ? mine : 1u; nx = cnt > 0u ? cnt : 1u;
}

__device__ __forceinline__ void xcd_barrier(const XcdBarrier& b) {
    asm volatile("s_waitcnt vmcnt(0)" ::: "memory");
    __syncthreads();
    if (threadIdx.x == 0) {
        unsigned* bar = b.bar;
        __builtin_amdgcn_s_waitcnt(0);
        unsigned nloc = b.st[0], nx = b.st[1];
        if (nloc == 0u) { xcd_barrier_complete(bar, b.x, nloc, nx); b.st[0] = nloc; b.st[1] = nx; }
        const unsigned old = xb_add(&bar[XB_XSUB(b.x)], 1u);
        const unsigned gen = old / nloc;
        if (old + 1u == (gen + 1u) * nloc) {
            __builtin_amdgcn_fence(__ATOMIC_RELEASE, "agent");
            asm volatile("s_waitcnt vmcnt(0)" ::: "memory");
            const unsigned og = xb_add(&bar[XB_TOP], 1u);
            const unsigned tg = og / nx;
            if (og + 1u == (tg + 1u) * nx) xb_add(&bar[XB_TOPGEN], 1u);
            else XB_SPIN(xb_ld(&bar[XB_TOPGEN]) == tg, bar);
            __builtin_amdgcn_fence(__ATOMIC_ACQUIRE, "agent");
            xb_add(&bar[XB_XGEN(b.x)], 1u);
            asm volatile("s_waitcnt vmcnt(0)" ::: "memory");
        } else {
            XB_SPIN(xb_ld(&bar[XB_XGEN(b.x)]) == gen, bar);
            __builtin_amdgcn_fence(__ATOMIC_ACQUIRE, "agent");
            asm volatile("s_waitcnt vmcnt(0)" ::: "memory");
        }
    }
    __syncthreads();
}

struct Frame {
    LAS unsigned char* lds;
    volatile LAS unsigned* MISC;
    gu32* ctl;
    unsigned char* ws;
    int tid, lane, wave, vcu, G;
};
template <int CTRL> __device__ __forceinline__ float dpp_f(float v) { return __builtin_bit_cast(float, __builtin_amdgcn_update_dpp(0, __builtin_bit_cast(int, v), CTRL, 0xF, 0xF, true)); }
__device__ __forceinline__ float wave_sum(float v) {
    v += dpp_f<0xB1>(v); v += dpp_f<0x4E>(v); v += dpp_f<0x141>(v); v += dpp_f<0x140>(v);
    { auto r = __builtin_amdgcn_permlane16_swap(__float_as_uint(v), __float_as_uint(v), false, false); v = __uint_as_float(r[0]) + __uint_as_float(r[1]); }
    { auto r = __builtin_amdgcn_permlane32_swap(__float_as_uint(v), __float_as_uint(v), false, false); v = __uint_as_float(r[0]) + __uint_as_float(r[1]); }
    return v;
}

__device__ __forceinline__ void transpose_item(const float* W, int N, int K, int k0, int n0, bf16* dst0, LAS float* scr_, int lane) {
    LAS unsigned* scr = (LAS unsigned*)scr_;
    const int n4 = (lane & 15) * 4, kq = lane >> 4;
    const float* src = W + (size_t)(k0 + 2 * kq) * N + n0 + n4;
    f32x4 a[8], b[8];
#pragma unroll
    for (int i = 0; i < 8; ++i) { a[i] = *(const f32x4*)(src + (size_t)(8 * i) * N); b[i] = *(const f32x4*)(src + (size_t)(8 * i + 1) * N); }
#pragma unroll
    for (int i = 0; i < 8; ++i) { LAS unsigned* d = scr + n4 * 33 + 4 * i + kq;
        d[0] = pk2(a[i].x, b[i].x); d[33] = pk2(a[i].y, b[i].y); d[66] = pk2(a[i].z, b[i].z); d[99] = pk2(a[i].w, b[i].w); }
    LDS_WAIT(); asm volatile("" ::: "memory");
    const int c = lane & 7;
#pragma unroll
    for (int j = 0; j < 8; ++j) { const int n = (lane >> 3) + 8 * j; const LAS unsigned* sp = scr + n * 33 + 4 * c;
        v4u o; o.x = sp[0]; o.y = sp[1]; o.z = sp[2]; o.w = sp[3];
        *(GAS v4u*)(dst0 + (size_t)n * K + k0 + 8 * c) = o; }
    LDS_WAIT(); asm volatile("" ::: "memory");
}
__device__ __forceinline__ void conv_plain(const float* W, int K, int N, bf16* WT, int item, LAS float* scr, int lane) {
    const int nblk = N / 64, kb = item / nblk, nb = item % nblk;
    transpose_item(W, N, K, 64 * kb, 64 * nb, WT + (size_t)(64 * nb) * K, scr, lane);
}
__device__ __forceinline__ void conv_gu(const float* W, int K, int N, bf16* WT, int up, int item, LAS float* scr, int lane) {
    const int nblk = N / 64, kb = item / nblk, nb = item % nblk, n0 = 64 * nb;
    transpose_item(W, N, K, 64 * kb, n0, WT + (size_t)((n0 >> 7) * 256 + up * 128 + (n0 & 127)) * K, scr, lane);
}
__device__ __forceinline__ unsigned fp8x4(float a, float b, float c, float d) { int r = 0; r = __builtin_amdgcn_cvt_pk_fp8_f32(a, b, r, false); r = __builtin_amdgcn_cvt_pk_fp8_f32(c, d, r, true); return (unsigned)r; }
__device__ __forceinline__ void transpose_item8(const float* W, int N, int K, int k0, int n0, unsigned char* dst0, float sc, LAS float* scr_, int lane) {
    LAS unsigned* scr = (LAS unsigned*)scr_;
    const int n4 = (lane & 15) * 4, kq = lane >> 4;
    const float* src = W + (size_t)(k0 + 4 * kq) * N + n0 + n4;
    f32x4 a[4][4];
#pragma unroll
    for (int i = 0; i < 4; ++i)
#pragma unroll
        for (int q = 0; q < 4; ++q) a[i][q] = *(const f32x4*)(src + (size_t)(16 * i + q) * N) * sc;
#pragma unroll
    for (int i = 0; i < 4; ++i) { LAS unsigned* d = scr + n4 * 17 + 4 * i + kq;
        d[0] = fp8x4(a[i][0].x, a[i][1].x, a[i][2].x, a[i][3].x); d[17] = fp8x4(a[i][0].y, a[i][1].y, a[i][2].y, a[i][3].y);
        d[34] = fp8x4(a[i][0].z, a[i][1].z, a[i][2].z, a[i][3].z); d[51] = fp8x4(a[i][0].w, a[i][1].w, a[i][2].w, a[i][3].w); }
    LDS_WAIT(); asm volatile("" ::: "memory");
    const int c = lane & 3;
#pragma unroll
    for (int j = 0; j < 4; ++j) { const int n = (lane >> 2) + 16 * j; const LAS unsigned* sp = scr + n * 17 + 4 * c;
        v4u o; o.x = sp[0]; o.y = sp[1]; o.z = sp[2]; o.w = sp[3];
        *(GAS v4u*)(dst0 + (size_t)n * K + k0 + 16 * c) = o; }
    LDS_WAIT(); asm volatile("" ::: "memory");
}
__device__ __forceinline__ void conv_plain8(const float* W, int K, int N, unsigned char* WT, int item, LAS float* scr, int lane) {
    const int nblk = N / 64, kb = item / nblk, nb = item % nblk;
    transpose_item8(W, N, K, 64 * kb, 64 * nb, WT + (size_t)(64 * nb) * K, WSC, scr, lane);
}
__device__ __forceinline__ void conv_gu8(const float* W, int K, int N, unsigned char* WT, int up, int item, LAS float* scr, int lane) {
    const int nblk = N / 64, kb = item / nblk, nb = item % nblk, n0 = 64 * nb;
    transpose_item8(W, N, K, 64 * kb, n0, WT + (size_t)((n0 >> 7) * 256 + up * 128 + (n0 & 127)) * K, WSC, scr, lane);
}
constexpr int IT_EG = (D / 64) * (DFFE / 64), IT_ED = (DFFE / 64) * (D / 64), IT_EXP_LAYER = NEXP * (2 * IT_EG + IT_ED);
__device__ __forceinline__ void conv_expert_item(const float* const* in, unsigned char* ws, int i, int it, LAS float* scr, int lane) {
    const int e = it / (2 * IT_EG + IT_ED); int r = it % (2 * IT_EG + IT_ED);
    const size_t eo = (size_t)(i * NEXP + e) * D * DFFE;
    bf16* gu = (bf16*)(ws + WS_WEGU) + (size_t)e * 2 * DFFE * D; bf16* dn = (bf16*)(ws + WS_WEDN) + (size_t)e * D * DFFE;
    const bool g8 = (i == 0) ? gu_fp8(1) : gu_fp8(3), d8 = (i == 0) ? dn_fp8(1) : dn_fp8(3);
    unsigned char* gu8 = ws + WS_WEGU + (size_t)e * 2 * DFFE * D; unsigned char* dn8 = ws + WS_WEDN + (size_t)e * D * DFFE;
    if (r < IT_EG) { if (g8) conv_gu8(in[19] + eo, D, DFFE, gu8, 0, r, scr, lane); else conv_gu(in[19] + eo, D, DFFE, gu, 0, r, scr, lane); return; } r -= IT_EG;
    if (r < IT_EG) { if (g8) conv_gu8(in[20] + eo, D, DFFE, gu8, 1, r, scr, lane); else conv_gu(in[20] + eo, D, DFFE, gu, 1, r, scr, lane); return; } r -= IT_EG;
    if (d8) conv_plain8(in[21] + eo, DFFE, D, dn8, r, scr, lane); else conv_plain(in[21] + eo, DFFE, D, dn, r, scr, lane);
}
__device__ __forceinline__ void conv_experts(Frame& F, const float* const* in, int i, int wg0 = 0, int nwg = 0) {
    int tid = F.tid; asm volatile("" : "+v"(tid)); const int lane = tid & 63; const int wave = __builtin_amdgcn_readfirstlane(tid >> 6); (void)lane; (void)wave;

    LAS float* scr = (LAS float*)(F.lds + wave * 16384);
    int gw = F.vcu * NWAVES + wave, NGW = F.G * NWAVES;
    if (nwg > 0) { const int r = (int)blockIdx.x - wg0; if (r < 0 || r >= nwg) return; gw = r * NWAVES + wave; NGW = nwg * NWAVES; }
    for (int it = gw; it < IT_EXP_LAYER; it += NGW) conv_expert_item(in, F.ws, i, it, scr, lane);
}
constexpr int IT_IN = (D / 64) * (INW / 64), IT_AO = (512 / 64) * (D / 64), IT_OUT = (D / 64) * (D / 64), IT_G = (D / 64) * (DFF / 64), IT_DN = (DFF / 64) * (D / 64);
constexpr int IT_DENSE = 4 * IT_IN + 4 * IT_AO + 4 * IT_OUT + 2 * (2 * IT_G + IT_DN);

__device__ __forceinline__ void p0_prologue(Frame& F, const float* const* in) {
    int tid = F.tid; asm volatile("" : "+v"(tid)); const int lane = tid & 63; const int wave = __builtin_amdgcn_readfirstlane(tid >> 6); (void)lane; (void)wave;

    unsigned char* ws = F.ws;
    {
        LAS float* sv = (LAS float*)F.lds;
        LAS float* red = (LAS float*)(F.lds + 20480);
        if (F.vcu < 192) {
            for (int idx = tid; idx < 5 * 1024; idx += 512) { const int r = idx >> 10, k = idx & 1023; const float v = r < 4 ? in[1][r * 1024 + k] : in[3][k]; sv[idx] = v * __builtin_amdgcn_rcpf(1.0f + fast_exp(-v)); }
            __syncthreads();
        }
        for (int it = F.vcu; it < 192; it += F.G) {
            const int l = it / 48, chunk = it % 48, col = chunk * 128 + 2 * lane;
            const float* W = in[4] + (size_t)l * D * 6144 + col;
            float a0[5], a1[5];
#pragma unroll
            for (int r = 0; r < 5; ++r) { a0[r] = 0.f; a1[r] = 0.f; }
            const int kb = wave * 128;
#pragma unroll 8
            for (int kk = 0; kk < 128; ++kk) { const int k = kb + kk; const f32x2 w = *(const f32x2*)(W + (size_t)k * 6144);
#pragma unroll
                for (int r = 0; r < 5; ++r) { const float s = sv[r * 1024 + k]; a0[r] += s * w.x; a1[r] += s * w.y; } }
#pragma unroll
            for (int r = 0; r < 5; ++r) { red[(wave * 5 + r) * 128 + 2 * lane] = a0[r]; red[(wave * 5 + r) * 128 + 2 * lane + 1] = a1[r]; }
            __syncthreads();
            for (int idx = tid; idx < 640; idx += 512) { const int r = idx >> 7, cc = idx & 127; float s = in[5][l * 6144 + chunk * 128 + cc];
#pragma unroll
                for (int w = 0; w < 8; ++w) s += red[(w * 5 + r) * 128 + cc];
                ((float*)(ws + WS_MOD))[(size_t)(l * 5 + r) * 6144 + chunk * 128 + cc] = s; }
            __syncthreads();
        }
        if (F.vcu == F.G - 1) {
            for (int idx = tid; idx < 2048; idx += 512) { const int pos = idx >> 4, i = idx & 15;
                const float freq = __builtin_amdgcn_exp2f(-(float)i * (13.287712379549449f / 16.0f)); const float ang = (float)pos * freq;
                double rev = (double)ang * 0.15915494309189535; rev -= (double)(long long)rev; const float rf = (float)rev;
                ((float*)(ws + WS_ROPE))[pos * 32 + i] = __builtin_amdgcn_cosf(rf); ((float*)(ws + WS_ROPE))[pos * 32 + 16 + i] = __builtin_amdgcn_sinf(rf); }
        }
        {
            const int gt = F.vcu * 512 + tid, NT = F.G * 512;
            for (int idx = gt; idx < 4 * 4 * 16 * 1024; idx += NT) { const int n = idx & 1023; const int ub = __builtin_amdgcn_readfirstlane(idx >> 10); const int kb = ub & 15, g = (ub >> 4) & 3, l = ub >> 6;
                const float* pw = in[10] + ((size_t)(l * 4 + g) * 128 + kb * 8) * 128; const float* ps = in[11] + l * 512 + 128 * g; const float* wp = in[12] + ((size_t)l * 512 + 128 * g) * 1024 + n;
                float acc[8];
#pragma unroll
                for (int i = 0; i < 8; ++i) acc[i] = 0.f;
#pragma unroll 16
                for (int c = 0; c < 128; ++c) { const float v = ps[c] * wp[(size_t)c * 1024];
#pragma unroll
                    for (int i = 0; i < 8; ++i) acc[i] += pw[i * 128 + c] * v; }
                v4u o; o.x = pk2(acc[0], acc[1]); o.y = pk2(acc[2], acc[3]); o.z = pk2(acc[4], acc[5]); o.w = pk2(acc[6], acc[7]);
                *(v4u*)((bf16*)(ws + WS_WPO) + (size_t)l * 1024 * 512 + (size_t)n * 512 + 128 * g + kb * 8) = o; }
        }
        __syncthreads();
    }
    LAS float* scr = (LAS float*)(F.lds + wave * 16384);
    const int gw = F.vcu * NWAVES + wave, NGW = F.G * NWAVES;
    for (int it = gw; it < IT_DENSE; it += NGW) {
        int r = it;
        if (r < 4 * IT_IN) { const int l = r / IT_IN, it2 = r % IT_IN; const int nblk = INW / 64, kb = it2 / nblk, nb = it2 % nblk;
            const float* Wl = in[7] + (size_t)l * D * INW; unsigned char* slot = ws + WS_WIN + (size_t)l * INW * D * 2;
            if (PF8) transpose_item8(Wl, INW, D, 64 * kb, 64 * nb, slot + (size_t)(64 * nb) * D, WSC, scr, lane);
            else if (QKV8) {
                const int n0 = 64 * nb;
                if (n0 >= 768 && n0 < NQKVP) transpose_item(Wl, INW, D, 64 * kb, n0, (bf16*)(slot + 3 * MiB) + (size_t)(n0 - 768) * D, scr, lane);
                else transpose_item8(Wl, INW, D, 64 * kb, n0, slot + (size_t)(n0 < 768 ? n0 : n0 - 512) * D, WSC, scr, lane);
            }
            else if (GATE8 && 64 * nb >= NQKVP) transpose_item8(Wl, INW, D, 64 * kb, 64 * nb, slot + (size_t)NQKVP * D * 2 + (size_t)(64 * nb - NQKVP) * D, WSC, scr, lane);
            else conv_plain(Wl, D, INW, (bf16*)slot, it2, scr, lane);
            continue; } r -= 4 * IT_IN;
        if (r < 4 * IT_AO) { const int l = r / IT_AO; conv_plain(in[9] + (size_t)l * 512 * D, 512, D, (bf16*)(ws + WS_WAO) + (size_t)l * D * 512, r % IT_AO, scr, lane); continue; } r -= 4 * IT_AO;
        if (r < 4 * IT_OUT) { const int l = r / IT_OUT; if (WOUT8) conv_plain8(in[13] + (size_t)l * D * D, D, D, ws + WS_WOUT + (size_t)l * D * D, r % IT_OUT, scr, lane);
            else conv_plain(in[13] + (size_t)l * D * D, D, D, (bf16*)(ws + WS_WOUT) + (size_t)l * D * D, r % IT_OUT, scr, lane); continue; } r -= 4 * IT_OUT;
        const int i = r / (2 * IT_G + IT_DN); r = r % (2 * IT_G + IT_DN);
        bf16* gu = (bf16*)(ws + WS_WGU) + (size_t)i * 2 * DFF * D; bf16* dn = (bf16*)(ws + WS_WDN) + (size_t)i * D * DFF;
        { unsigned char* gu8 = ws + WS_W8GU + (size_t)i * 2 * DFF * D; unsigned char* dn8 = ws + WS_W8DN + (size_t)i * D * DFF; const bool g8 = gu_fp8(2 * i), d8 = dn_fp8(2 * i);
          if (r < IT_G) { if (g8) conv_gu8(in[14] + (size_t)i * D * DFF, D, DFF, gu8, 0, r, scr, lane); else conv_gu(in[14] + (size_t)i * D * DFF, D, DFF, gu, 0, r, scr, lane); continue; } r -= IT_G;
          if (r < IT_G) { if (g8) conv_gu8(in[15] + (size_t)i * D * DFF, D, DFF, gu8, 1, r, scr, lane); else conv_gu(in[15] + (size_t)i * D * DFF, D, DFF, gu, 1, r, scr, lane); continue; } r -= IT_G;
          if (d8) { conv_plain8(in[16] + (size_t)i * DFF * D, DFF, D, dn8, r, scr, lane); continue; } }
        conv_plain(in[16] + (size_t)i * DFF * D, DFF, D, dn, r, scr, lane);
    }
    if (!CONV0_TAIL) conv_experts(F, in, 0);
}

__device__ __forceinline__ const float* xrow_ptr(const float* lat, const float* ctx, int m) { return m < M_LAT ? lat + (size_t)m * D : ctx + (size_t)(m - M_LAT) * D; }
__device__ __forceinline__ float* xrow_ptr(float* lat, float* ctx, int m) { return m < M_LAT ? lat + (size_t)m * D : ctx + (size_t)(m - M_LAT) * D; }
__device__ __forceinline__ int mod_row(int m) { return m < M_LAT ? (m >> 13) : 4; }

__device__ __forceinline__ void load_row_f32(const float* p, f32x4 (&v)[4], int lane) {
#pragma unroll
    for (int j = 0; j < 4; ++j) v[j] = *(const f32x4*)(p + 256 * j + 4 * lane);
}
__device__ __forceinline__ void load_row_bf16(const bf16* p, f32x4 (&v)[4], int lane) {
#pragma unroll
    for (int j = 0; j < 4; ++j) { const v2u w = *(const v2u*)(p + 256 * j + 4 * lane); v[j] = (f32x4){bflo(w.x), bfhi(w.x), bflo(w.y), bfhi(w.y)}; }
}
__device__ __forceinline__ float row_rstd(const f32x4 (&v)[4]) {
    float ss = 0.f;
#pragma unroll
    for (int j = 0; j < 4; ++j) ss += (v[j].x * v[j].x + v[j].y * v[j].y) + (v[j].z * v[j].z + v[j].w * v[j].w);
    return __builtin_amdgcn_rsqf(wave_sum(ss) * (1.0f / D) + EPS);
}
__device__ __forceinline__ void norm_mod_store(const f32x4 (&v)[4], const f32x4 (&b1)[4], const f32x4 (&b2)[4], bf16* orow, int lane, bool valid, unsigned char* orow8 = nullptr) {
    const float rstd = row_rstd(v);
#pragma unroll
    for (int j = 0; j < 4; ++j) { const f32x4 h = (v[j] * rstd) * b1[j] + b2[j]; v2u w; w.x = pk2(h.x, h.y); w.y = pk2(h.z, h.w); if (valid) { if (!PF8) *(v2u*)(orow + 256 * j + 4 * lane) = w;
        if (GATE8 && orow8) *(unsigned*)(orow8 + 256 * j + 4 * lane) = pg8::pack_fp8x4(h.x * ASC, h.y * ASC, h.z * ASC, h.w * ASC); } }
}
struct RowDeal { int gwL, nwL, gwC, nwC; };
__device__ __forceinline__ RowDeal row_deal(const Frame& F, int wave, int nl) {
    RowDeal d;
    if (nl <= 0) { d.gwL = d.gwC = F.vcu * NWAVES + wave; d.nwL = d.nwC = F.G * NWAVES; }
    else { const int bx = (int)blockIdx.x; if (bx < nl) { d.gwL = -1; d.nwL = 1; d.gwC = bx * NWAVES + wave; d.nwC = nl * NWAVES; } else { d.gwL = (bx - nl) * NWAVES + wave; d.nwL = (F.G - nl) * NWAVES; d.gwC = -1; d.nwC = 1; } }
    return d;
}
__device__ __forceinline__ void wave_rows(const RowDeal& d, int seg, int& lo, int& hi) {
    if (seg == 0) { if (d.gwL < 0) { lo = hi = 0; return; } const int rpw = (M_LAT + d.nwL - 1) / d.nwL; lo = d.gwL * rpw; hi = lo + rpw < M_LAT ? lo + rpw : M_LAT; }
    else { if (d.gwC < 0) { lo = hi = 0; return; } const int rpw = (M_CTX + d.nwC - 1) / d.nwC; lo = M_LAT + d.gwC * rpw; hi = lo + rpw < M ? lo + rpw : M; }
    if (lo > hi) lo = hi;
}
__device__ __forceinline__ void hand_wait(const Frame& F, gu32* hand, int nl, int nseg, int wave, unsigned want) {
    if (!hand) return;
    if (wave == 0) {
        for (int seg = 0; seg < nseg; ++seg) { int lo, hi, lo7, hi7; const RowDeal d0 = row_deal(F, 0, nl), d7 = row_deal(F, NWAVES - 1, nl); wave_rows(d0, seg, lo, hi); wave_rows(d7, seg, lo7, hi7);
            if (hi7 > lo7) hi = hi7; if (lo >= hi) continue;
            for (int p = lo >> 8; p <= ((hi - 1) >> 8); ++p) { unsigned spins = 0;
                while ((unsigned)__builtin_amdgcn_readfirstlane(__hip_atomic_load(hand + 64 * p, RLX_AGENT)) < want) { __builtin_amdgcn_s_sleep(8);
                    if (++spins > (1u << 21)) { __hip_atomic_store(F.ctl + 2, 1u, RLX_AGENT); break; } } } }
        __builtin_amdgcn_fence(__ATOMIC_ACQUIRE, "agent"); asm volatile("s_waitcnt vmcnt(0)" ::: "memory");
    }
    __syncthreads();
}
__device__ __forceinline__ void ph_norm1(Frame& F, const float* const* in, int l, const float* xl, const float* xc) {
    int tid = F.tid; asm volatile("" : "+v"(tid)); const int lane = tid & 63; const int wave = __builtin_amdgcn_readfirstlane(tid >> 6);
    const int gw = F.vcu * NWAVES + wave, NGW = F.G * NWAVES;
    const float* mod = (const float*)(F.ws + WS_MOD) + (size_t)l * 5 * 6144; const float* ng = in[6] + (size_t)l * 4 * D;
    const RowDeal rd = row_deal(F, wave, 0); (void)gw; (void)NGW;
    for (int seg = 0; seg < 2; ++seg) { int lo, hi; wave_rows(rd, seg, lo, hi); const int n = hi - lo; int cur = -1; f32x4 b1[4], b2[4]; f32x4 rx[3][4];
#pragma unroll
        for (int u = 0; u < 3; ++u) if (u < n) load_row_f32(xrow_ptr(xl, xc, lo + u), rx[u], lane);
        for (int i = 0; i < n; i += 3) {
#pragma unroll
            for (int u = 0; u < 3; ++u) { if (i + u < n) { const int m = lo + i + u; const int mr = mod_row(m);
                if (mr != cur) { cur = mr; const float* mp = mod + mr * 6144;
#pragma unroll
                    for (int j = 0; j < 4; ++j) { const int c = 256 * j + 4 * lane; b1[j] = *(const f32x4*)(ng + c) * (*(const f32x4*)(mp + 1024 + c) + 1.0f); b2[j] = *(const f32x4*)(mp + c); } }
                f32x4 x[4];
#pragma unroll
                for (int j = 0; j < 4; ++j) x[j] = rx[u][j];
                if (i + u + 3 < n) load_row_f32(xrow_ptr(xl, xc, m + 3), rx[u], lane);
                norm_mod_store(x, b1, b2, (bf16*)(F.ws + WS_XN) + (size_t)m * D, lane, true, F.ws + WS_AR + AR_XN8 + (size_t)m * D); } } }
    }
}
struct Tiles {
    int c0, c1, c2, c3, c4, c5, c6, c7, n0, n1, n2, n3, n4, n5, n6, n7;
    __device__ __forceinline__ void load(const gu32* fill) {
#define TL_(e) c##e = (int)__builtin_amdgcn_readfirstlane(__hip_atomic_load(fill + 64 * e, RLX_AGENT)); n##e = (c##e + 255) >> 8;
        TL_(0) TL_(1) TL_(2) TL_(3) TL_(4) TL_(5) TL_(6) TL_(7)
#undef TL_
    }
    __device__ __forceinline__ int f1() const { return n0; }
    __device__ __forceinline__ int f2() const { return n0 + n1; }
    __device__ __forceinline__ int f3() const { return n0 + n1 + n2; }
    __device__ __forceinline__ int f4() const { return n0 + n1 + n2 + n3; }
    __device__ __forceinline__ int f5() const { return n0 + n1 + n2 + n3 + n4; }
    __device__ __forceinline__ int f6() const { return n0 + n1 + n2 + n3 + n4 + n5; }
    __device__ __forceinline__ int f7() const { return n0 + n1 + n2 + n3 + n4 + n5 + n6; }
    __device__ __forceinline__ int nt() const { return n0 + n1 + n2 + n3 + n4 + n5 + n6 + n7; }
    __device__ __forceinline__ int first(int e) const { return (e > 0 ? n0 : 0) + (e > 1 ? n1 : 0) + (e > 2 ? n2 : 0) + (e > 3 ? n3 : 0) + (e > 4 ? n4 : 0) + (e > 5 ? n5 : 0) + (e > 6 ? n6 : 0); }
    __device__ __forceinline__ int cnt(int e) const { return (e == 0 ? c0 : 0) + (e == 1 ? c1 : 0) + (e == 2 ? c2 : 0) + (e == 3 ? c3 : 0) + (e == 4 ? c4 : 0) + (e == 5 ? c5 : 0) + (e == 6 ? c6 : 0) + (e == 7 ? c7 : 0); }
    __device__ __forceinline__ int expert_of(int pm) const { return (pm >= f1()) + (pm >= f2()) + (pm >= f3()) + (pm >= f4()) + (pm >= f5()) + (pm >= f6()) + (pm >= f7()); }
};

struct MidVec { f32x4 a1[4], a2[4], sf[4]; };
__device__ __forceinline__ void mid_row(Frame& F, const MidVec& V, f32x4 (&y)[4], f32x4 (&x)[4], int m, bool valid, bool moe, bool f8, float* xo, const float* br, LAS float* wr, LAS float* recw, int& nrec, int lane) {
    const float rstd = row_rstd(y);
#pragma unroll
    for (int j = 0; j < 4; ++j) { x[j] = x[j] + V.a1[j] * (y[j] * rstd);
        if (valid) { if (XBF16) { v2u w; w.x = pk2(x[j].x, x[j].y); w.y = pk2(x[j].z, x[j].w); *(v2u*)((bf16*)(F.ws + WS_XB) + (size_t)m * D + 256 * j + 4 * lane) = w; } else *(f32x4*)(xo + 256 * j + 4 * lane) = x[j]; } }
    const float rstd2 = row_rstd(x);
    unsigned char* orow8 = F.ws + WS_AR + AR_XF + (size_t)m * D; bf16* orow = (bf16*)(F.ws + WS_AR + AR_XF) + (size_t)m * D;
    float lg[8];
#pragma unroll
    for (int e = 0; e < 8; ++e) lg[e] = 0.f;
#pragma unroll
    for (int j = 0; j < 4; ++j) { const int c = 256 * j + 4 * lane; const f32x4 h = (x[j] * rstd2) * V.a2[j] + V.sf[j];
        if (valid) { if (f8) { *(unsigned*)(orow8 + c) = pg8::pack_fp8x4(h.x * ASC, h.y * ASC, h.z * ASC, h.w * ASC); } else { v2u w; w.x = pk2(h.x, h.y); w.y = pk2(h.z, h.w); *(v2u*)(orow + c) = w; } }
        if (moe) {
#pragma unroll
            for (int e = 0; e < 8; ++e) { const f32x4 wv = *(const LAS f32x4*)(wr + e * 1024 + c); lg[e] += (h.x * wv.x + h.y * wv.y) + (h.z * wv.z + h.w * wv.w); } } }
    if (moe) {
#pragma unroll
        for (int e = 0; e < 8; ++e) lg[e] = wave_sum(lg[e]) + br[e];
        float b0 = lg[0]; int i0 = 0;
#pragma unroll
        for (int e = 1; e < 8; ++e) if (lg[e] > b0) { b0 = lg[e]; i0 = e; }
        float b1 = -3.0e38f; int i1 = 0;
#pragma unroll
        for (int e = 0; e < 8; ++e) if (e != i0 && lg[e] > b1) { b1 = lg[e]; i1 = e; }
        const float w0 = 1.0f / (1.0f + fast_exp(b1 - b0));
        if (valid) { if (lane == 0) { LAS float* r = recw + nrec * 4; r[0] = __uint_as_float((unsigned)(i0 | (i1 << 4))); r[1] = w0; r[2] = 1.0f - w0; r[3] = __uint_as_float((unsigned)m); } ++nrec; }
    }
}
__device__ __forceinline__ void ph_mid(Frame& F, const float* const* in, int l, const float* xil, const float* xic, float* xol, float* xoc, gu32* hand, int nl) {
    int tid = F.tid; asm volatile("" : "+v"(tid)); const int lane = tid & 63; const int wave = __builtin_amdgcn_readfirstlane(tid >> 6);
    const int gw = F.vcu * NWAVES + wave, NGW = F.G * NWAVES; const bool moe = (l & 1) != 0; const bool f8 = gu_fp8(l);
    const float* mod = (const float*)(F.ws + WS_MOD) + (size_t)l * 5 * 6144; const float* ng = in[6] + (size_t)l * 4 * D;
    const bf16* Y = (const bf16*)(F.ws + WS_AR + AR_Y);
    LAS float* wr = (LAS float*)F.lds;
    LAS float* rec = (LAS float*)(F.lds + 32768);
    LAS unsigned* lcnt = (LAS unsigned*)(F.lds + 32768 + 8192);
    if (moe) {
        const float* wrt = in[17] + (size_t)(l >> 1) * D * NEXP;
        for (int idx = tid; idx < D * NEXP; idx += 512) { const int c = idx >> 3, e = idx & 7; wr[e * 1024 + c] = wrt[idx]; }
        if (tid < 24) lcnt[tid] = 0u;
        __syncthreads();
    }
    const float* br = in[18] + (l >> 1) * NEXP;
    int nrec = 0; LAS float* recw = rec + wave * 64 * 4;
    const int nseg = (l == DEPTH - 1) ? 1 : 2;
    const RowDeal rd = row_deal(F, wave, nl); (void)gw; (void)NGW;
    hand_wait(F, hand, nl, nseg, wave, 32u);
    for (int seg = 0; seg < nseg; ++seg) { int lo, hi; wave_rows(rd, seg, lo, hi); const int n = hi - lo; int cur = -1; MidVec V;
        v2u ry[3][4]; f32x4 rx[3][4]; v2u rxb[3][4];
        const bool xin32 = !XBF16 || l == 0; const bf16* XB = (const bf16*)(F.ws + WS_XB);
#define MID_LOAD(u, m_) do { const bf16* yp_ = Y + (size_t)(m_) * D; const float* xp_ = xrow_ptr(xil, xic, (m_)); _Pragma("unroll") for (int j = 0; j < 4; ++j) { ry[u][j] = *(const v2u*)(yp_ + 256 * j + 4 * lane); if (xin32) rx[u][j] = *(const f32x4*)(xp_ + 256 * j + 4 * lane); else rxb[u][j] = *(const v2u*)(XB + (size_t)(m_) * D + 256 * j + 4 * lane); } } while (0)
#pragma unroll
        for (int u = 0; u < 3; ++u) if (u < n) MID_LOAD(u, lo + u);
        for (int i = 0; i < n; i += 3) {
#pragma unroll
            for (int u = 0; u < 3; ++u) { if (i + u < n) { const int m = lo + i + u; const int mr = mod_row(m);
                if (mr != cur) { cur = mr; const float* mp = mod + mr * 6144;
#pragma unroll
                    for (int j = 0; j < 4; ++j) { const int c = 256 * j + 4 * lane; V.a1[j] = *(const f32x4*)(mp + 2048 + c) * *(const f32x4*)(ng + D + c);
                        V.a2[j] = *(const f32x4*)(ng + 2 * D + c) * (*(const f32x4*)(mp + 4096 + c) + 1.0f); V.sf[j] = *(const f32x4*)(mp + 3072 + c); } }
                f32x4 y[4], x[4];
#pragma unroll
                for (int j = 0; j < 4; ++j) { const v2u w = ry[u][j]; y[j] = (f32x4){bflo(w.x), bfhi(w.x), bflo(w.y), bfhi(w.y)}; if (xin32) x[j] = rx[u][j]; else { const v2u b = rxb[u][j]; x[j] = (f32x4){bflo(b.x), bfhi(b.x), bflo(b.y), bfhi(b.y)}; } }
                if (i + u + 3 < n) MID_LOAD(u, m + 3);
                mid_row(F, V, y, x, m, true, moe, f8, xrow_ptr(xol, xoc, m), br, wr, recw, nrec, lane); } } }
#undef MID_LOAD
    }
    if (moe) {
        if (lane == 0) lcnt[16 + wave] = (unsigned)nrec;
        __syncthreads();
        gu32* fill = F.ctl + CW_FILL + (l >> 1) * 8 * 64;
        const int w = tid >> 6, ii = tid & 63; const bool valid = ii < (int)lcnt[16 + w];
        unsigned ee = 0u; float w0 = 0.f, w1 = 0.f; unsigned r0 = 0u, r1 = 0u; int m = 0;
        if (valid) { const LAS float* r = rec + (w * 64 + ii) * 4; ee = __float_as_uint(r[0]); w0 = r[1]; w1 = r[2]; m = (int)__float_as_uint(r[3]);
            r0 = __hip_atomic_fetch_add(lcnt + (ee & 15u), 1u, __ATOMIC_RELAXED, __HIP_MEMORY_SCOPE_WORKGROUP); r1 = __hip_atomic_fetch_add(lcnt + (ee >> 4), 1u, __ATOMIC_RELAXED, __HIP_MEMORY_SCOPE_WORKGROUP); }
        __syncthreads();
        if (tid < 8) lcnt[8 + tid] = __hip_atomic_fetch_add(fill + 64 * tid, lcnt[tid], RLX_AGENT);
        __syncthreads();
        if (valid) { const unsigned e0 = ee & 15u, e1 = ee >> 4; const unsigned s0 = lcnt[8 + e0] + r0, s1 = lcnt[8 + e1] + r1;
            int* list = (int*)(F.ws + WS_LIST); list[(size_t)e0 * M + s0] = m; list[(size_t)e1 * M + s1] = m;
            unsigned* ts = (unsigned*)(F.ws + WS_TOKSLOT); ts[2 * m] = e0 | (s0 << 3); ts[2 * m + 1] = e1 | (s1 << 3);
            float* tw = (float*)(F.ws + WS_TOKW); tw[2 * m] = w0; tw[2 * m + 1] = w1; }
        __syncthreads();
    }
}
__device__ __forceinline__ void ph_end(Frame& F, const float* const* in, int l, float* xl, float* xc, gu32* hand, int nl) {
    int tid = F.tid; asm volatile("" : "+v"(tid)); const int lane = tid & 63; const int wave = __builtin_amdgcn_readfirstlane(tid >> 6);
    const int gw = F.vcu * NWAVES + wave, NGW = F.G * NWAVES; const bool moe = (l & 1) != 0; const bool nxt = l + 1 < DEPTH;
    const float* mod = (const float*)(F.ws + WS_MOD) + (size_t)l * 5 * 6144; const float* ng = in[6] + (size_t)l * 4 * D;
    const bf16* Y = (const bf16*)(F.ws + WS_AR + AR_XG);
    Tiles T; T.load(F.ctl + CW_FILL + (l >> 1) * 8 * 64);
    const int nseg = (l == DEPTH - 1) ? 1 : 2;
    const RowDeal rd = row_deal(F, wave, nl); (void)gw; (void)NGW;
    hand_wait(F, hand, nl, nseg, wave, 32u);
    for (int seg = 0; seg < nseg; ++seg) { int lo, hi; wave_rows(rd, seg, lo, hi); const int n = hi - lo; int cur = -1; f32x4 a3[4], b1[4], b2[4];
        int p0v = 0, p1v = 0; float w0v = 0.f, w1v = 0.f;
        if (moe && lane < n) { const unsigned* ts = (const unsigned*)(F.ws + WS_TOKSLOT); const float* tw = (const float*)(F.ws + WS_TOKW); const int m = lo + lane;
            const unsigned s0 = ts[2 * m], s1 = ts[2 * m + 1]; w0v = tw[2 * m]; w1v = tw[2 * m + 1];
            p0v = T.first((int)(s0 & 7u)) * 256 + (int)(s0 >> 3); p1v = T.first((int)(s1 & 7u)) * 256 + (int)(s1 >> 3); }
        v2u ry[3][4], rz[3][4]; f32x4 rx[3][4]; v2u rxb[3][4]; const bf16* XB = (const bf16*)(F.ws + WS_XB); const bool lastl = (l == DEPTH - 1);
#define END_LOAD(u, i_) do { const int m_ = lo + (i_); const float* xp_ = xrow_ptr(xl, xc, m_); \
            if (moe) { const int q0_ = __builtin_amdgcn_readlane(p0v, (i_)), q1_ = __builtin_amdgcn_readlane(p1v, (i_)); const bf16* ya_ = Y + (size_t)q0_ * D; const bf16* yb_ = Y + (size_t)q1_ * D; \
                _Pragma("unroll") for (int j = 0; j < 4; ++j) { ry[u][j] = *(const v2u*)(ya_ + 256 * j + 4 * lane); rz[u][j] = *(const v2u*)(yb_ + 256 * j + 4 * lane); } } \
            else { const bf16* ya_ = Y + (size_t)m_ * D; _Pragma("unroll") for (int j = 0; j < 4; ++j) ry[u][j] = *(const v2u*)(ya_ + 256 * j + 4 * lane); } \
            _Pragma("unroll") for (int j = 0; j < 4; ++j) { if (XBF16) rxb[u][j] = *(const v2u*)(XB + (size_t)m_ * D + 256 * j + 4 * lane); else rx[u][j] = *(const f32x4*)(xp_ + 256 * j + 4 * lane); } } while (0)
#pragma unroll
        for (int u = 0; u < 3; ++u) if (u < n) END_LOAD(u, u);
        for (int i = 0; i < n; i += 3) {
#pragma unroll
            for (int u = 0; u < 3; ++u) { if (i + u < n) { const int m = lo + i + u; const int mr = mod_row(m);
                if (mr != cur) { cur = mr; const float* mp = mod + mr * 6144; const float* mp2 = mp + 5 * 6144;
#pragma unroll
                    for (int j = 0; j < 4; ++j) { const int c = 256 * j + 4 * lane; a3[j] = *(const f32x4*)(mp + 5120 + c) * *(const f32x4*)(ng + 3 * D + c);
                        if (nxt) { b1[j] = *(const f32x4*)(ng + 4 * D + c) * (*(const f32x4*)(mp2 + 1024 + c) + 1.0f); b2[j] = *(const f32x4*)(mp2 + c); } else { b1[j] = a3[j]; b2[j] = a3[j]; } } }
                f32x4 y[4], x[4];
                if (moe) { const float w0 = __uint_as_float(__builtin_amdgcn_readlane(__float_as_uint(w0v), i + u)), w1 = __uint_as_float(__builtin_amdgcn_readlane(__float_as_uint(w1v), i + u));
#pragma unroll
                    for (int j = 0; j < 4; ++j) { const v2u a = ry[u][j], b = rz[u][j];
                        y[j] = (f32x4){bflo(a.x), bfhi(a.x), bflo(a.y), bfhi(a.y)} * w0 + (f32x4){bflo(b.x), bfhi(b.x), bflo(b.y), bfhi(b.y)} * w1; } }
                else {
#pragma unroll
                    for (int j = 0; j < 4; ++j) { const v2u a = ry[u][j]; y[j] = (f32x4){bflo(a.x), bfhi(a.x), bflo(a.y), bfhi(a.y)}; } }
#pragma unroll
                for (int j = 0; j < 4; ++j) { if (XBF16) { const v2u b = rxb[u][j]; x[j] = (f32x4){bflo(b.x), bfhi(b.x), bflo(b.y), bfhi(b.y)}; } else x[j] = rx[u][j]; }
                if (i + u + 3 < n) END_LOAD(u, i + u + 3);
                float* xp = xrow_ptr(xl, xc, m);
                const float rstd = row_rstd(y);
#pragma unroll
                for (int j = 0; j < 4; ++j) { x[j] = x[j] + a3[j] * (y[j] * rstd);
                    if (XBF16 && !lastl) { v2u w; w.x = pk2(x[j].x, x[j].y); w.y = pk2(x[j].z, x[j].w); *(v2u*)((bf16*)(F.ws + WS_XB) + (size_t)m * D + 256 * j + 4 * lane) = w; } else *(f32x4*)(xp + 256 * j + 4 * lane) = x[j]; }
                if (nxt) norm_mod_store(x, b1, b2, (bf16*)(F.ws + WS_XN) + (size_t)m * D, lane, true, F.ws + WS_AR + AR_XN8 + (size_t)m * D); } } }
#undef END_LOAD
    }
}
template <int H> __device__ __forceinline__ void pooled_item(const bf16* P, bf16* PO, int m, int c8, int t, int L, int base) {
    v4u w[2 * H]; float s[8];
#pragma unroll
    for (int k = 0; k < 2 * H; ++k) { int r = t - H + k; r = r < 0 ? 0 : (r >= L ? L - 1 : r); w[k] = *(const v4u*)(P + (size_t)(base + r) * 512 + c8); }
#pragma unroll
    for (int j = 0; j < 8; ++j) s[j] = 0.f;
#pragma unroll
    for (int k = 0; k < 2 * H; ++k) { const int r = t - H + k; const float ok = (r >= 0 && r < L) ? 1.0f : 0.0f; const v4u x = w[k];
        s[0] += ok * bflo(x.x); s[1] += ok * bfhi(x.x); s[2] += ok * bflo(x.y); s[3] += ok * bfhi(x.y); s[4] += ok * bflo(x.z); s[5] += ok * bfhi(x.z); s[6] += ok * bflo(x.w); s[7] += ok * bfhi(x.w); }
    const int lo = t - H < 0 ? 0 : t - H, hi = t + H > L ? L : t + H; const float inv = 1.0f / (float)(hi - lo); const v4u c = w[H];
    v4u o; o.x = pk2(s[0] * inv - bflo(c.x), s[1] * inv - bfhi(c.x)); o.y = pk2(s[2] * inv - bflo(c.y), s[3] * inv - bfhi(c.y));
    o.z = pk2(s[4] * inv - bflo(c.z), s[5] * inv - bfhi(c.z)); o.w = pk2(s[6] * inv - bflo(c.w), s[7] * inv - bfhi(c.w));
    *(v4u*)(PO + (size_t)m * 512 + c8) = o;
}
__device__ __forceinline__ void ph_pooled(Frame& F, int rows) {
    int tid = F.tid; asm volatile("" : "+v"(tid)); const int lane = tid & 63; const int wave = __builtin_amdgcn_readfirstlane(tid >> 6);
    const bf16* P = (const bf16*)(F.ws + WS_AR + AR_P); bf16* PO = (bf16*)(F.ws + WS_AR + AR_POOLED);
    const int gw = F.vcu * NWAVES + wave, NGW = F.G * NWAVES, nitems = rows;
    int k = 0;
    for (int j = gw; j < nitems; j += NGW, ++k) { const int gi = ((j & 3) + k) & 3, q = j >> 2;
        const int m = 4 * q + (lane >> 4), c8 = gi * 128 + (lane & 15) * 8;
        int t, L, base; if (m < M_LAT) { t = m & 8191; L = SEQ; base = m - t; } else { t = (m - M_LAT) & 255; L = CTXL; base = m - t; }
        if (gi == 0) pooled_item<1>(P, PO, m, c8, t, L, base); else if (gi == 1) pooled_item<2>(P, PO, m, c8, t, L, base);
        else if (gi == 2) pooled_item<4>(P, PO, m, c8, t, L, base); else pooled_item<8>(P, PO, m, c8, t, L, base); }
}

constexpr float ATT_THR = 8.0f;
constexpr int AT_KP = 144, AT_VP = 136;
constexpr int AT_KB = 64 * AT_KP, AT_VB = 64 * AT_VP;
__device__ __forceinline__ void attn_unit(Frame& F, int b, int kvh, int qb, bool lat, const float* sinks) {
    int tid = F.tid; asm volatile("" : "+v"(tid)); const int lane = tid & 63; const int wave = __builtin_amdgcn_readfirstlane(tid >> 6); (void)lane; (void)wave;

    const int wid = wave, r32 = lane & 31, hi = lane >> 5;
    const bf16* Q = (const bf16*)(F.ws + WS_AR + AR_Q); const bf16* Kg = (const bf16*)(F.ws + WS_AR + AR_K); const bf16* VT = (const bf16*)(F.ws + WS_AR + AR_VT); bf16* O = (bf16*)(F.ws + WS_AR + AR_ATT);
    const int hq = kvh * 4 + (wid >> 1);
    const int qrow = (lat ? b * SEQ + qb * 64 : M_LAT + b * CTXL + qb * 64) + (wid & 1) * 32 + r32;
    bf16x8 qf[4];
#pragma unroll
    for (int d0 = 0; d0 < 4; ++d0) qf[d0] = *(const bf16x8*)(Q + (size_t)qrow * 512 + hq * 64 + d0 * 16 + hi * 8);
    int t_lo = 0, n_loc = 0;
    if (lat) { t_lo = qb - 2 < 0 ? 0 : qb - 2; const int t_hi = qb + 2 > 127 ? 127 : qb + 2; n_loc = t_hi - t_lo + 1; }
    const int nt = n_loc + 4;
    const int srow = tid >> 3, sch = tid & 7;
    const bf16* vbase = VT + ((size_t)((b * 2 + kvh) * 64 + srow)) * VTP + sch * 8;
    LAS unsigned char* kl = F.lds + srow * AT_KP + sch * 16; LAS unsigned char* vl = F.lds + 2 * AT_KB + srow * AT_VP + sch * 16;
    v4u kreg, vreg, kreg2, vreg2;
#define AT_LOAD(KR, VR, t) do { const int _t = (t); int krow, kk0; if (_t < n_loc) { kk0 = (t_lo + _t) * 64; krow = b * SEQ + kk0; } else { kk0 = SEQ + (_t - n_loc) * 64; krow = M_LAT + b * CTXL + (_t - n_loc) * 64; } \
        KR = *(const v4u*)(Kg + (size_t)(krow + srow) * 128 + kvh * 64 + sch * 8); VR = *(const v4u*)(vbase + kk0); } while (0)
    AT_LOAD(kreg, vreg, 0); if (1 < nt) AT_LOAD(kreg2, vreg2, 1);
    const float sk = sinks[hq] * 1.4426950408889634f;
    float mst = sk, lrun = hi == 0 ? 1.0f : 0.0f;
    f32x16 negm;
#pragma unroll
    for (int r = 0; r < 16; ++r) negm[r] = -mst;
    f32x16 o0 = {}, o1 = {};
    const int qpos = qb * 64 + (wid & 1) * 32 + r32;
#define AT_TILE(KR, VR, TT) do { \
        const int buf = (TT) & 1; \
        *(LAS v4u*)(kl + buf * AT_KB) = KR; { LAS v2u* vp = (LAS v2u*)(vl + buf * AT_VB); vp[0] = (v2u){VR.x, VR.y}; vp[1] = (v2u){VR.z, VR.w}; } \
        __syncthreads(); \
        if ((TT) + 2 < nt) AT_LOAD(KR, VR, (TT) + 2); \
        const LAS unsigned char* kb = F.lds + buf * AT_KB + r32 * AT_KP + hi * 16; const LAS unsigned char* vb = F.lds + 2 * AT_KB + buf * AT_VB + r32 * AT_VP + hi * 8; \
        f32x16 p0 = negm, p1 = negm; \
_Pragma("unroll") \
        for (int d0 = 0; d0 < 4; ++d0) { const bf16x8 k0 = *(const LAS bf16x8*)(kb + d0 * 32), k1 = *(const LAS bf16x8*)(kb + 32 * AT_KP + d0 * 32); \
            p0 = __builtin_amdgcn_mfma_f32_32x32x16_bf16(k0, qf[d0], p0, 0, 0, 0); p1 = __builtin_amdgcn_mfma_f32_32x32x16_bf16(k1, qf[d0], p1, 0, 0, 0); } \
        if ((TT) < n_loc) { const int tk = t_lo + (TT); if (tk == qb - 2 || tk == qb + 2) { const int kbase = tk * 64 + 4 * hi; \
_Pragma("unroll") \
                for (int r = 0; r < 16; ++r) { const int kp = kbase + (r & 3) + 8 * (r >> 2); int dd = qpos - kp; dd = dd < 0 ? -dd : dd; if (dd > 128) p0[r] = -INFINITY; int d2 = qpos - kp - 32; d2 = d2 < 0 ? -d2 : d2; if (d2 > 128) p1[r] = -INFINITY; } } } \
        float mxa = fmaxf(fmaxf(p0[0], p0[1]), p1[0]), mxb = fmaxf(fmaxf(p0[2], p0[3]), p1[1]); mxa = fmaxf(fmaxf(mxa, p1[2]), p1[3]); \
_Pragma("unroll") \
        for (int r = 4; r < 16; r += 4) { mxa = fmaxf(fmaxf(mxa, p0[r]), p0[r + 1]); mxb = fmaxf(fmaxf(mxb, p0[r + 2]), p0[r + 3]); mxa = fmaxf(fmaxf(mxa, p1[r]), p1[r + 1]); mxb = fmaxf(fmaxf(mxb, p1[r + 2]), p1[r + 3]); } \
        float rm = fmaxf(mxa, mxb); \
        { auto rr = __builtin_amdgcn_permlane32_swap(__float_as_uint(rm), __float_as_uint(rm), false, false); rm = fmaxf(__uint_as_float(rr[0]), __uint_as_float(rr[1])); } \
        if (__builtin_expect(__any(rm > ATT_THR), 0)) {            \
            const float dl = fmaxf(rm, 0.f); mst += dl; \
_Pragma("unroll") \
            for (int r = 0; r < 16; ++r) { p0[r] -= dl; p1[r] -= dl; negm[r] = -mst; } \
            const float f = __builtin_amdgcn_exp2f(-dl); lrun *= f; \
_Pragma("unroll") \
            for (int r = 0; r < 16; ++r) { o0[r] *= f; o1[r] *= f; } \
        } \
        float lsa = 0.f, lsb = 0.f; \
_Pragma("unroll") \
        for (int r = 0; r < 16; ++r) { p0[r] = __builtin_amdgcn_exp2f(p0[r]); p1[r] = __builtin_amdgcn_exp2f(p1[r]); lsa += p0[r]; lsb += p1[r]; } \
        lrun += lsa + lsb; \
        bf16x8 pb[4]; \
_Pragma("unroll") \
        for (int s = 0; s < 2; ++s) { v4u w; w.x = pk2(p0[8 * s], p0[8 * s + 1]); w.y = pk2(p0[8 * s + 2], p0[8 * s + 3]); w.z = pk2(p0[8 * s + 4], p0[8 * s + 5]); w.w = pk2(p0[8 * s + 6], p0[8 * s + 7]); pb[s] = __builtin_bit_cast(bf16x8, w); \
            v4u x; x.x = pk2(p1[8 * s], p1[8 * s + 1]); x.y = pk2(p1[8 * s + 2], p1[8 * s + 3]); x.z = pk2(p1[8 * s + 4], p1[8 * s + 5]); x.w = pk2(p1[8 * s + 6], p1[8 * s + 7]); pb[2 + s] = __builtin_bit_cast(bf16x8, x); } \
_Pragma("unroll") \
        for (int ks = 0; ks < 4; ++ks) {                  \
            const int ko = ((ks >> 1) * 32 + (ks & 1) * 16) * 2; \
            const v2u a0 = *(const LAS v2u*)(vb + ko), a1 = *(const LAS v2u*)(vb + ko + 16), c0 = *(const LAS v2u*)(vb + 32 * AT_VP + ko), c1 = *(const LAS v2u*)(vb + 32 * AT_VP + ko + 16); \
            const v4u va = (v4u){a0.x, a0.y, a1.x, a1.y}, vc = (v4u){c0.x, c0.y, c1.x, c1.y}; \
            o0 = __builtin_amdgcn_mfma_f32_32x32x16_bf16(__builtin_bit_cast(bf16x8, va), pb[ks], o0, 0, 0, 0); \
            o1 = __builtin_amdgcn_mfma_f32_32x32x16_bf16(__builtin_bit_cast(bf16x8, vc), pb[ks], o1, 0, 0, 0); } \
    } while (0)
    for (int t = 0; t < nt; t += 2) { AT_TILE(kreg, vreg, t); if (t + 1 < nt) AT_TILE(kreg2, vreg2, t + 1); }
#undef AT_TILE
#undef AT_LOAD
    { auto rr = __builtin_amdgcn_permlane32_swap(__float_as_uint(lrun), __float_as_uint(lrun), false, false); lrun = __uint_as_float(rr[0]) + __uint_as_float(rr[1]); }
    const float inv = 1.0f / lrun;
    bf16* orow = O + (size_t)qrow * 512 + hq * 64 + 4 * hi;
#pragma unroll
    for (int a = 0; a < 4; ++a) { v2u w; w.x = pk2(o0[4 * a] * inv, o0[4 * a + 1] * inv); w.y = pk2(o0[4 * a + 2] * inv, o0[4 * a + 3] * inv); *(v2u*)(orow + 8 * a) = w;
        v2u x; x.x = pk2(o1[4 * a] * inv, o1[4 * a + 1] * inv); x.y = pk2(o1[4 * a + 2] * inv, o1[4 * a + 3] * inv); *(v2u*)(orow + 32 + 8 * a) = x; }
    __syncthreads();
}
__device__ __forceinline__ void ph_attn(Frame& F, const float* sinks, int nunits) {
    for (int u = F.vcu; u < nunits; u += F.G) {
        if (u < 1024) { const int bh = u >> 7, qb = u & 127; attn_unit(F, bh >> 1, bh & 1, qb, true, sinks); }
        else { const int v = u - 1024; const int bh = v >> 2, qb = v & 3; attn_unit(F, bh >> 1, bh & 1, qb, false, sinks); }
    }
}


#ifndef MK_HANDOFF
#define MK_HANDOFF 0
#endif
#ifndef MK_ONE_LAUNCH
#define MK_ONE_LAUNCH 1
#endif
struct Args { const float* in[22]; float* out; unsigned char* ws; int ph_lo, ph_hi; };
__global__ void __launch_bounds__(NWAVES * 64, 2) fwd_kernel(Args args) {
    extern __shared__ __attribute__((aligned(16))) unsigned char lds[];
    Frame F;
    F.lds = (LAS unsigned char*)lds; F.MISC = (volatile LAS unsigned*)(F.lds + MISC_OFF);
    F.tid = threadIdx.x; F.lane = F.tid & 63; F.wave = __builtin_amdgcn_readfirstlane(F.tid >> 6);
    F.G = gridDim.x; { const int bx = blockIdx.x; F.vcu = (F.G % 8 == 0) ? (bx % 8) * (F.G / 8) + bx / 8 : bx; }
    F.ws = args.ws; F.ctl = (gu32*)(args.ws + WS_CTL);
    for (int u = F.tid; u < (LDS_BYTES - LDSCTL_OFF) / 4; u += NWAVES * 64) ((LAS unsigned*)(F.lds + LDSCTL_OFF))[u] = 0u;
    __syncthreads();
    const int lo = args.ph_lo, hi = args.ph_hi;
    XcdBarrier bar; bar.bar = (unsigned*)(F.ctl + CW_BAR); bar.x = 0; bar.st = nullptr;
    if (hi - lo > 1) bar = xcd_barrier_post((unsigned*)(F.ctl + CW_BAR), F.MISC + 8);
#define RUN(p) (lo <= (p) && (p) < hi)
#define PHASE_END(p) do { if ((p) + 1 < hi) xcd_barrier(bar); } while (0)
    const float* const* in = args.in;
    unsigned char* ws = args.ws;
    float* const xl = args.out; float* const xc = (float*)(ws + WS_CTXS);
    const int bx = (int)blockIdx.x;

    if (RUN(0)) { p0_prologue(F, in); PHASE_END(0); }

    for (int l = 0; l < DEPTH; ++l) {
        const int pb = 1 + 11 * l;
        if (hi <= pb) break;
        if (lo >= pb + 11) continue;
        const bool moe = (l & 1) != 0;
        const bool lastl = (l == DEPTH - 1); const int nMt = lastl ? M_LAT / 256 : M / 256;
        pg8::bf16_t* const XN = (pg8::bf16_t*)(ws + WS_XN);
        unsigned char* const ar = ws + WS_AR;
        if (RUN(pb + 0) && l == 0) { ph_norm1(F, in, 0, in[0], in[2]); PHASE_END(pb + 0); }
        if (RUN(pb + 1)) {
            unsigned char* const slot = ws + WS_WIN + (size_t)l * INW * D * 2;
            if (PF8) {
                { pg8::Gemm g8{(const pg8::bf16_t*)(ar + AR_XN8), (const pg8::bf16_t*)slot, M, NQKVP, D / 2}; pg8::GroupOrder S8; S8.init(M / 256, NQKVP, F.G, bx);
                  pg8::EpiIn E8{(pg8::bf16_t*)(ar + AR_Q), (pg8::bf16_t*)(ar + AR_K), (pg8::bf16_t*)(ar + AR_VT), (pg8::bf16_t*)(ar + AR_P), (pg8::bf16_t*)(ar + AR_G), (const float*)(ws + WS_ROPE), C2, 1.0f / (WSC * ASC), 5};
                  pg8::gemm_phase<pg8::EpiIn, pg8::GroupOrder, true, true, true>(F.lds, g8, S8, E8); }
                { pg8::Gemm g8{(const pg8::bf16_t*)(ar + AR_XN8), (const pg8::bf16_t*)(slot + (size_t)NQKVP * D), M, 2048, D / 2}; pg8::GroupOrder S8; S8.init(M / 256, 2048, F.G, bx);
                  pg8::EpiGate8 E8{(pg8::bf16_t*)(ar + AR_G), 1.0f / (WSC * ASC)};
                  pg8::gemm_phase<pg8::EpiGate8, pg8::GroupOrder, true, true, true>(F.lds, g8, S8, E8); }
            } else if (QKV8 && QKV1) {
                { pg8::Gemm g8{(const pg8::bf16_t*)(ar + AR_XN8), (const pg8::bf16_t*)slot, M, 2816, D / 2}; pg8::GroupOrder S8; S8.init(M / 256, 2816, F.G, bx);
                  pg8::EpiIn E8{(pg8::bf16_t*)(ar + AR_Q), (pg8::bf16_t*)(ar + AR_K), (pg8::bf16_t*)(ar + AR_VT), (pg8::bf16_t*)(ar + AR_P), (pg8::bf16_t*)(ar + AR_G), (const float*)(ws + WS_ROPE), C2, 1.0f / (WSC * ASC), 3};
                  pg8::gemm_phase<pg8::EpiIn, pg8::GroupOrder, true, true, true>(F.lds, g8, S8, E8); }
                { pg8::Gemm g{XN, (const pg8::bf16_t*)(slot + 3 * MiB), M, 512, D}; pg8::GroupOrder S; S.init(M / 256, 512, F.G, bx);
                  pg8::EpiCol8<0> E{(pg8::bf16_t*)(ar + AR_P), 512, nullptr, 0, nullptr, nullptr, 1.0f};
                  pg8::gemm_phase<pg8::EpiCol8<0>, pg8::GroupOrder, true, true>(F.lds, g, S, E); }
            } else if (QKV8) {
                const int G_ = F.G, o1 = (((M / 256) * 3) % G_ + 7) & ~7, o2 = ((o1 + nMt * 8) % G_ + 7) & ~7; const int c1 = (bx + G_ - o1 % G_) % G_, c2 = (bx + G_ - o2 % G_) % G_;
                { pg8::Gemm g8{(const pg8::bf16_t*)(ar + AR_XN8), (const pg8::bf16_t*)slot, M, 768, D / 2}; pg8::GroupOrder S8; S8.init(M / 256, 768, F.G, bx);
                  pg8::EpiIn E8{(pg8::bf16_t*)(ar + AR_Q), (pg8::bf16_t*)(ar + AR_K), (pg8::bf16_t*)(ar + AR_VT), (pg8::bf16_t*)(ar + AR_P), (pg8::bf16_t*)(ar + AR_G), (const float*)(ws + WS_ROPE), C2, 1.0f / (WSC * ASC), 3};
                  pg8::gemm_phase<pg8::EpiIn, pg8::GroupOrder, true, true, true>(F.lds, g8, S8, E8); }
                { pg8::Gemm g8{(const pg8::bf16_t*)(ar + AR_XN8), (const pg8::bf16_t*)(slot + (size_t)768 * D), M, 2048, D / 2}; pg8::GroupOrder S8; S8.init(nMt, 2048, F.G, c1);
                  pg8::EpiGate8 E8{(pg8::bf16_t*)(ar + AR_G), 1.0f / (WSC * ASC)};
                  pg8::gemm_phase<pg8::EpiGate8, pg8::GroupOrder, true, true, true>(F.lds, g8, S8, E8); }
                { pg8::Gemm g{XN, (const pg8::bf16_t*)(slot + 3 * MiB), M, 512, D}; pg8::GroupOrder S; S.init(nMt, 512, F.G, c2);
                  pg8::EpiCol8<0> E{(pg8::bf16_t*)(ar + AR_P), 512, nullptr, 0, nullptr, nullptr, 1.0f};
                  pg8::gemm_phase<pg8::EpiCol8<0>, pg8::GroupOrder, true, true>(F.lds, g, S, E); }
            } else {
            pg8::Gemm g{XN, (const pg8::bf16_t*)slot, M, GATE8 ? NQKVP : INW, D}; pg8::GroupOrder S; S.init(M / 256, GATE8 ? NQKVP : INW, F.G, bx);
            pg8::EpiIn E{(pg8::bf16_t*)(ar + AR_Q), (pg8::bf16_t*)(ar + AR_K), (pg8::bf16_t*)(ar + AR_VT), (pg8::bf16_t*)(ar + AR_P), (pg8::bf16_t*)(ar + AR_G), (const float*)(ws + WS_ROPE), C2, 1.0f, 5};
            pg8::gemm_phase<pg8::EpiIn, pg8::GroupOrder, true, true>(F.lds, g, S, E);
            if (GATE8) {
                pg8::Gemm g8{(const pg8::bf16_t*)(ar + AR_XN8), (const pg8::bf16_t*)(slot + (size_t)NQKVP * D * 2), M, 2048, D / 2}; pg8::GroupOrder S8; S8.init(M / 256, 2048, F.G, bx);
                pg8::EpiGate8 E8{(pg8::bf16_t*)(ar + AR_G), 1.0f / (WSC * ASC)};
                pg8::gemm_phase<pg8::EpiGate8, pg8::GroupOrder, true, true, true>(F.lds, g8, S8, E8); }
            }
            PHASE_END(pb + 1);
        }
        if (RUN(pb + 2)) {
            const bool cv = (l == 2), cvfirst = (F.vcu & 1) != 0;
            for (int step = 0; step < 2; ++step) { if (cv && ((step == 0) == cvfirst)) conv_experts(F, in, 1); if (step == (cv && cvfirst ? 1 : 0)) { ph_attn(F, in[8] + l * 8, lastl ? 1024 : 1056); ph_pooled(F, lastl ? M_LAT : M); } if (cv) __syncthreads(); }
            PHASE_END(pb + 2); }
        if (RUN(pb + 3)) {
            { pg8::Gemm g{(const pg8::bf16_t*)(ar + AR_ATT), (const pg8::bf16_t*)(ws + WS_WAO) + (size_t)l * D * 512, M, D, 512}; pg8::GroupOrder S; S.init(nMt, D, F.G, bx);
              pg8::EpiCol8<1, false> E{(pg8::bf16_t*)(ar + AR_T1), D, (const pg8::bf16_t*)(ar + AR_G), 0, nullptr, nullptr, 1.0f};
              pg8::gemm_phase<pg8::EpiCol8<1, false>, pg8::GroupOrder, true, true>(F.lds, g, S, E); }
            { pg8::Gemm g{(const pg8::bf16_t*)(ar + AR_POOLED), (const pg8::bf16_t*)(ws + WS_WPO) + (size_t)l * D * 512, M, D, 512}; pg8::GroupOrder S; S.init(nMt, D, F.G, bx);
              pg8::EpiCol8<WOUT8 ? 4 : 2> E{(pg8::bf16_t*)(ar + AR_MERGED), D, (const pg8::bf16_t*)(ar + AR_G), 1024, (const pg8::bf16_t*)(ar + AR_T1), nullptr, WOUT8 ? ASC : 1.0f};
              pg8::gemm_phase<pg8::EpiCol8<WOUT8 ? 4 : 2>, pg8::GroupOrder, true, true>(F.lds, g, S, E); }
            PHASE_END(pb + 3);
        }
        const int nl_mix = nMt * 4 > 2 * F.G ? nMt * 4 - 2 * F.G : 0;
        gu32* const hand_mix = F.ctl + CW_HAND + l * HAND_BANK;
        if (RUN(pb + 5)) {
            pg8::Gemm g{(const pg8::bf16_t*)(ar + AR_MERGED), WOUT8 ? (const pg8::bf16_t*)(ws + WS_WOUT + (size_t)l * D * D) : (const pg8::bf16_t*)(ws + WS_WOUT) + (size_t)l * D * D, M, D, WOUT8 ? D / 2 : D}; pg8::GroupOrder S; S.init(nMt, D, F.G, bx);
            const bool ho = MK_HANDOFF && RUN(pb + 6); if (ho) S.hand = (unsigned*)hand_mix;
            pg8::EpiCol8<0, (MK_HANDOFF != 0)> E{(pg8::bf16_t*)(ar + AR_Y), D, nullptr, 0, nullptr, nullptr, WOUT8 ? 1.0f / (WSC * ASC) : 1.0f};
            pg8::gemm_phase<pg8::EpiCol8<0, (MK_HANDOFF != 0)>, pg8::GroupOrder, true, true, (WOUT8 != 0)>(F.lds, g, S, E);
            if (!ho) PHASE_END(pb + 5);
        }
        if (RUN(pb + 6)) {
            { const bool hi_ = MK_HANDOFF && RUN(pb + 5); gu32* hd = hi_ ? hand_mix : nullptr; const int nl = hi_ ? nl_mix : 0;
              if (l == 0) ph_mid(F, in, l, in[0], in[2], xl, xc, hd, nl); else ph_mid(F, in, l, xl, xc, xl, xc, hd, nl); }
            PHASE_END(pb + 6);
        }
        if (RUN(pb + 8)) {
            const bool f8 = gu_fp8(l), o8 = dn_fp8(l); const int esz = f8 ? 1 : 2;
            pg8::GroupOrder S; pg8::Gemm g;
            const int ff = moe ? DFFE : DFF;
            LAS unsigned short* rl = (LAS unsigned short*)(F.lds + RL_OFF);
            if (moe) { Tiles T; T.load(F.ctl + CW_FILL + (l >> 1) * 8 * 64);
                g = pg8::Gemm{(const pg8::bf16_t*)(ar + AR_XF), (const pg8::bf16_t*)(ws + WS_WEGU), T.nt() * 256, 2 * DFFE, D * esz / 2}; S.init(T.nt(), 2 * DFFE, F.G, bx);
                S.t1 = T.f1(); S.t2 = T.f2(); S.t3 = T.f3(); S.t4 = T.f4(); S.t5 = T.f5(); S.t6 = T.f6(); S.t7 = T.f7(); S.estride = (size_t)2 * DFFE * D * esz;
                const int* list = (const int*)(ws + WS_LIST);
                for (int i0 = 0; i0 < RL_UNITS; i0 += 10) { int tok[10];
#pragma unroll
                    for (int d = 0; d < 10; ++d) { pg8::Unit u; tok[d] = -1; if (S.next(i0 + d, u)) { const int e = T.expert_of(u.pm); const int local = (u.pm - T.first(e)) * 256 + (F.tid & 255);
                        tok[d] = (F.tid < 256 && local < T.cnt(e)) ? list[(size_t)e * M + local] : 0; } }
#pragma unroll
                    for (int d = 0; d < 10; ++d) if (tok[d] >= 0 && F.tid < 256) rl[(i0 + d) * 256 + F.tid] = (unsigned short)tok[d]; }
            } else {
                { pg8::GroupOrder S0; S0.init(M / 256, 2 * DFF, F.G, bx);
                  for (int i = 0; i < RL_UNITS; ++i) { pg8::Unit u; if (!S0.next(i, u)) break; if (F.tid < 256) rl[i * 256 + F.tid] = (unsigned short)(u.pm * 256 + F.tid); } }
                const unsigned char* wb = f8 ? ws + WS_W8GU + (size_t)(l >> 1) * 2 * DFF * D : ws + WS_WGU + (size_t)(l >> 1) * 2 * DFF * D * 2;
                g = pg8::Gemm{(const pg8::bf16_t*)(ar + AR_XF), (const pg8::bf16_t*)wb, M, 2 * DFF, D * esz / 2}; S.init(M / 256, 2 * DFF, F.G, bx);
            }
            S.rl = (const LAS unsigned short*)rl; __syncthreads();
            if (any_combo(true, true) && f8 && o8) { pg8::EpiSwiglu<true, true> E{(void*)(ar + AR_HID), ff, 1.0f / (WSC * ASC), HSC}; pg8::gemm_phase<pg8::EpiSwiglu<true, true>, pg8::GroupOrder, true, true, true, true>(F.lds, g, S, E); }
            if (any_combo(true, false) && f8 && !o8) { pg8::EpiSwiglu<true, false> E{(void*)(ar + AR_HID), ff, 1.0f / (WSC * ASC), 1.0f}; pg8::gemm_phase<pg8::EpiSwiglu<true, false>, pg8::GroupOrder, true, true, true, true>(F.lds, g, S, E); }
            if (any_combo(false, true) && !f8 && o8) { pg8::EpiSwiglu<false, true> E{(void*)(ar + AR_HID), ff, 1.0f, HSC}; pg8::gemm_phase<pg8::EpiSwiglu<false, true>, pg8::GroupOrder, true, true, false, true>(F.lds, g, S, E); }
            if (any_combo(false, false) && !f8 && !o8) { pg8::EpiSwiglu<false, false> E{(void*)(ar + AR_HID), ff, 1.0f, 1.0f}; pg8::gemm_phase<pg8::EpiSwiglu<false, false>, pg8::GroupOrder, true, true, false, true>(F.lds, g, S, E); }
            PHASE_END(pb + 8);
        }
        if (RUN(pb + 9)) {
            const bool f8 = dn_fp8(l); const int esz = f8 ? 1 : 2;
            pg8::GroupOrder S; pg8::Gemm g; pg8::EpiCol8<0, (MK_HANDOFF != 0)> E{(pg8::bf16_t*)(ar + AR_XG), D, nullptr, 0, nullptr, nullptr, f8 ? 1.0f / (WSC * HSC) : 1.0f};
            const bool ho = MK_HANDOFF && !moe && RUN(pb + 10);
            if (moe) { Tiles T; T.load(F.ctl + CW_FILL + (l >> 1) * 8 * 64);
                g = pg8::Gemm{(const pg8::bf16_t*)(ar + AR_HID), (const pg8::bf16_t*)(ws + WS_WEDN), T.nt() * 256, D, DFFE * esz / 2}; S.init(T.nt(), D, F.G, bx);
                S.t1 = T.f1(); S.t2 = T.f2(); S.t3 = T.f3(); S.t4 = T.f4(); S.t5 = T.f5(); S.t6 = T.f6(); S.t7 = T.f7(); S.estride = (size_t)D * DFFE * esz;
            } else {
                const unsigned char* wb = f8 ? ws + WS_W8DN + (size_t)(l >> 1) * D * DFF : ws + WS_WDN + (size_t)(l >> 1) * D * DFF * 2;
                g = pg8::Gemm{(const pg8::bf16_t*)(ar + AR_HID), (const pg8::bf16_t*)wb, M, D, DFF * esz / 2}; S.init(M / 256, D, F.G, bx);
                if (ho) S.hand = (unsigned*)(F.ctl + CW_HAND + (4 + (l >> 1)) * HAND_BANK);
            }
            if ((FP8DN & 0xF) != 0 && f8) pg8::gemm_phase<pg8::EpiCol8<0, (MK_HANDOFF != 0)>, pg8::GroupOrder, true, true, true>(F.lds, g, S, E);
            if ((FP8DN & 0xF) != 0xF && !f8) pg8::gemm_phase<pg8::EpiCol8<0, (MK_HANDOFF != 0)>, pg8::GroupOrder, true, true, false>(F.lds, g, S, E);
            if (CONV0_TAIL && l == 0) { const int nx = (M / 256) * 4 - 2 * F.G; __syncthreads(); if (nx > 0 && nx < F.G) conv_experts(F, in, 0, nx, F.G - nx); else conv_experts(F, in, 0); }
            if (!ho) PHASE_END(pb + 9);
        }
        if (RUN(pb + 10)) { const bool hi_ = MK_HANDOFF && !moe && RUN(pb + 9); const int nld = (M / 256) * 4 > 2 * F.G ? (M / 256) * 4 - 2 * F.G : 0;
            ph_end(F, in, l, xl, xc, hi_ ? F.ctl + CW_HAND + (4 + (l >> 1)) * HAND_BANK : nullptr, hi_ ? nld : 0); PHASE_END(pb + 10); }
    }
#undef RUN
#undef PHASE_END
}

extern "C" void kernel_launch(void* const* d_in, const int* in_sizes, int n_in, void* d_out, int out_size, void* d_ws, size_t ws_size, hipStream_t stream) {
    static int grid = 0;
    if (grid == 0) {
        if (n_in != 22 || in_sizes[0] != M_LAT * D || out_size != M_LAT * D || ws_size < WS_END) { fprintf(stderr, "kernel_launch: unexpected shapes (n_in %d, out %d, ws %zu < %zu); nothing launched\n", n_in, out_size, ws_size, (size_t)WS_END); grid = -1; return; }
        int dev = 0, cus = 0, per_cu = 0;
        if (hipGetDevice(&dev) != hipSuccess || hipDeviceGetAttribute(&cus, hipDeviceAttributeMultiprocessorCount, dev) != hipSuccess) { grid = -1; return; }
        if (hipFuncSetAttribute((const void*)fwd_kernel, hipFuncAttributeMaxDynamicSharedMemorySize, LDS_BYTES) != hipSuccess) { fprintf(stderr, "kernel_launch: hipFuncSetAttribute failed\n"); grid = -1; return; }
        if (hipOccupancyMaxActiveBlocksPerMultiprocessor(&per_cu, (const void*)fwd_kernel, NWAVES * 64, LDS_BYTES) != hipSuccess || per_cu < 1) { fprintf(stderr, "kernel_launch: occupancy query reports %d blocks per CU\n", per_cu); }
        (void)hipGetLastError();
        grid = cus;
        if (grid * RL_UNITS < 272 * 28) { fprintf(stderr, "kernel_launch: %d CUs: the gathered GEMM's LDS row lists are sized for >= 254 workgroups; nothing launched\n", grid); grid = -1; return; }
    }
    if (grid < 0) return;
    if (hipMemsetAsync((char*)d_ws + WS_CTL, 0, CTL_ZERO_BYTES, stream) != hipSuccess) return;
    Args a{};
    for (int i = 0; i < 22; ++i) a.in[i] = (const float*)d_in[i];
    a.out = (float*)d_out; a.ws = (unsigned char*)d_ws;
#if MK_ONE_LAUNCH
    a.ph_lo = 0; a.ph_hi = NPH;
    hipLaunchKernelGGL(fwd_kernel, dim3(grid), dim3(NWAVES * 64), LDS_BYTES, stream, a);
#else
    for (int p = 0; p < NPH; ++p) {
        const int k = (p - 1) % 11, l = (p - 1) / 11;
        if (p > 0 && ((k == 0 && l != 0) || k == 4 || k == 7)) continue;
        a.ph_lo = p; a.ph_hi = p + 1;
        hipLaunchKernelGGL(fwd_kernel, dim3(grid), dim3(NWAVES * 64), LDS_BYTES, stream, a);
    }
#endif
}
```
